# Optimizing an MI355X kernel written in HIP

```python
import math
import jax, jax.numpy as jnp
from jax import lax
import numpy as np

D_MODEL = 2048
BATCH = 4
SEQ = 4096
DEPTH = 2

N_TOKEN_MIXERS = 2
EPS = 1e-6
MASK_VALUE = -1e30

CHUNK = 128
GMLP_WIDTH = 2 * D_MODEL
GMLP_GROUPS = 8
GMLP_GROUP_DIM = GMLP_WIDTH // GMLP_GROUPS

HEAD_DIM = 64
N_HEADS = D_MODEL // HEAD_DIM
N_KV_HEADS = max(1, N_HEADS // 8)
GQA_GROUP = N_HEADS // N_KV_HEADS
WINDOW = 128
ATTN_BLOCK = 128
ROT_DIM = HEAD_DIM // 4
ROPE_THETA = 500000.0

D_FF = ((8 * D_MODEL // 3 + 255) // 256) * 256
N_EXPERTS = 8
TOP_K = 2
D_FF_EXPERT = 7 * D_MODEL // 2

N_EVEN = (DEPTH + 1) // 2
N_ODD = DEPTH // 2

kernel_name = 'hybrid_gmlp_swa_sink_moe_adaln'


def _rms(x, g):
    xf = x.astype(jnp.float32)
    y = xf * lax.rsqrt(jnp.mean(xf * xf, axis=-1, keepdims=True) + EPS)
    return (y * g.astype(jnp.float32)).astype(x.dtype)


def _layernorm(x, g, b):
    xf = x.astype(jnp.float32)
    mu = jnp.mean(xf, axis=-1, keepdims=True)
    xc = xf - mu
    var = jnp.mean(xc * xc, axis=-1, keepdims=True)
    y = xc * lax.rsqrt(var + EPS) * g.astype(jnp.float32) + b.astype(jnp.float32)
    return y.astype(x.dtype)


def _rope_partial(x, cos, sin):
    x1 = x[..., : ROT_DIM // 2]
    x2 = x[..., ROT_DIM // 2: ROT_DIM]
    xp = x[..., ROT_DIM:]
    return jnp.concatenate([x1 * cos - x2 * sin, x2 * cos + x1 * sin, xp], axis=-1)


def _swiglu(h, w_gu, w_d):
    g, u = jnp.split(h @ w_gu, 2, axis=-1)
    return (jax.nn.silu(g) * u) @ w_d


def _gmlp_mixer(h, w_in, b_in, ln_g, ln_b, w_s, b_s, w_out):
    B, S, _ = h.shape
    z = jax.nn.gelu(h @ w_in + b_in, approximate=False)
    u, v = jnp.split(z, 2, axis=-1)
    v = _layernorm(v, ln_g, ln_b)
    v = v.reshape(B, S // CHUNK, CHUNK, GMLP_GROUPS, GMLP_GROUP_DIM)
    causal = jnp.tril(jnp.ones((CHUNK, CHUNK), dtype=bool))
    ws = jnp.where(causal[None], w_s, 0.0).astype(v.dtype)
    mixed = jnp.einsum('gts,bcsgd->bctgd', ws, v) + b_s.T[:, :, None].astype(v.dtype)
    return (u * mixed.reshape(B, S, GMLP_WIDTH)) @ w_out


def _swa_sink_attention(h, w_qkv, q_norm_g, k_norm_g, sinks, w_o, cos, sin):
    B, S, _ = h.shape
    nb = S // ATTN_BLOCK
    qkv = h @ w_qkv
    q, k, v = jnp.split(qkv, [N_HEADS * HEAD_DIM, (N_HEADS + N_KV_HEADS) * HEAD_DIM], axis=-1)
    q = _rms(q.reshape(B, S, N_HEADS, HEAD_DIM), q_norm_g)
    k = _rms(k.reshape(B, S, N_KV_HEADS, HEAD_DIM), k_norm_g)
    v = v.reshape(B, S, N_KV_HEADS, HEAD_DIM)
    q = _rope_partial(q, cos, sin)
    k = _rope_partial(k, cos, sin)

    qb = q.reshape(B, nb, ATTN_BLOCK, N_KV_HEADS, GQA_GROUP, HEAD_DIM)
    pad = jnp.zeros((B, ATTN_BLOCK, N_KV_HEADS, HEAD_DIM), k.dtype)
    kp = jnp.concatenate([pad, k], axis=1).reshape(B, nb + 1, ATTN_BLOCK, N_KV_HEADS, HEAD_DIM)
    vp = jnp.concatenate([pad, v], axis=1).reshape(B, nb + 1, ATTN_BLOCK, N_KV_HEADS, HEAD_DIM)
    kw = jnp.concatenate([kp[:, :-1], kp[:, 1:]], axis=2)
    vw = jnp.concatenate([vp[:, :-1], vp[:, 1:]], axis=2)

    scores = jnp.einsum('bnqkgd,bnrkd->bnkgqr', qb, kw,
                        preferred_element_type=jnp.float32) * (HEAD_DIM ** -0.5)
    qi = jnp.arange(ATTN_BLOCK)[:, None]
    ri = jnp.arange(2 * ATTN_BLOCK)[None, :]
    diff = qi + ATTN_BLOCK - ri
    band = (diff >= 0) & (diff < WINDOW)
    key_pos = jnp.arange(nb)[:, None] * ATTN_BLOCK + ri - ATTN_BLOCK
    valid = band[None] & (key_pos >= 0)[:, None, :]
    scores = jnp.where(valid[None, :, None, None], scores, MASK_VALUE)

    sink = sinks.astype(jnp.float32).reshape(N_KV_HEADS, GQA_GROUP)[None, None, :, :, None, None]
    m = jnp.maximum(jnp.max(scores, axis=-1, keepdims=True), sink)
    p = jnp.exp(scores - m)
    probs = p / (jnp.sum(p, axis=-1, keepdims=True) + jnp.exp(sink - m))
    out = jnp.einsum('bnkgqr,bnrkd->bnqkgd', probs.astype(vw.dtype), vw)
    return out.reshape(B, S, N_HEADS * HEAD_DIM) @ w_o


def _moe(h, router_w, router_b, w_gate_up, w_down):
    logits = h.astype(jnp.float32) @ router_w.astype(jnp.float32) + router_b.astype(jnp.float32)
    top_vals, top_idx = lax.top_k(logits, TOP_K)
    top_w = jax.nn.softmax(top_vals, axis=-1)
    gates = jnp.sum(jax.nn.one_hot(top_idx, N_EXPERTS, dtype=jnp.float32) * top_w[..., None], axis=-2)
    gates = gates.astype(h.dtype)
    y = jnp.zeros_like(h)
    for e in range(N_EXPERTS):
        y = y + gates[..., e:e + 1] * _swiglu(h, w_gate_up[e], w_down[e])
    return y


def setup_inputs(seed: int = 0) -> dict:
    key = jax.random.key(seed)
    ks = jax.random.split(key, 26)

    def nrm(k, shape, scale):
        return jax.random.normal(k, shape, jnp.float32) * scale

    D = D_MODEL
    offsets = jax.random.randint(ks[2], (BATCH, 1), 0, 4096, dtype=jnp.int32)
    positions = offsets + jnp.arange(SEQ, dtype=jnp.int32)[None, :]
    qkv_out = (N_HEADS + 2 * N_KV_HEADS) * HEAD_DIM
    return {
        'x': nrm(ks[0], (BATCH, SEQ, D), 1.0),
        'c': nrm(ks[1], (BATCH, D), 1.0),
        'positions': positions,
        'ada_w': nrm(ks[3], (DEPTH, D, 6 * D), D ** -0.5),
        'ada_b': nrm(ks[4], (DEPTH, 6 * D), 0.02),
        'norm_g': 1.0 + nrm(ks[5], (DEPTH, 2, D), 0.02),
        'gmlp_w_in': nrm(ks[6], (N_EVEN, D, 2 * GMLP_WIDTH), D ** -0.5),
        'gmlp_b_in': nrm(ks[7], (N_EVEN, 2 * GMLP_WIDTH), 0.02),
        'gmlp_ln_g': 1.0 + nrm(ks[8], (N_EVEN, GMLP_WIDTH), 0.02),
        'gmlp_ln_b': nrm(ks[9], (N_EVEN, GMLP_WIDTH), 0.02),
        'gmlp_w_s': nrm(ks[10], (N_EVEN, GMLP_GROUPS, CHUNK, CHUNK), CHUNK ** -0.5),
        'gmlp_b_s': 1.0 + nrm(ks[11], (N_EVEN, GMLP_GROUPS, CHUNK), 0.02),
        'gmlp_w_out': nrm(ks[12], (N_EVEN, GMLP_WIDTH, D), GMLP_WIDTH ** -0.5),
        'attn_w_qkv': nrm(ks[13], (N_ODD, D, qkv_out), D ** -0.5),
        'attn_q_norm_g': 1.0 + nrm(ks[14], (N_ODD, HEAD_DIM), 0.02),
        'attn_k_norm_g': 1.0 + nrm(ks[15], (N_ODD, HEAD_DIM), 0.02),
        'attn_sinks': nrm(ks[16], (N_ODD, N_HEADS), 1.0),
        'attn_w_o': nrm(ks[17], (N_ODD, N_HEADS * HEAD_DIM, D), (N_HEADS * HEAD_DIM) ** -0.5),
        'ffn_w_gate_up': nrm(ks[18], (N_EVEN, D, 2 * D_FF), D ** -0.5),
        'ffn_w_down': nrm(ks[19], (N_EVEN, D_FF, D), D_FF ** -0.5),
        'moe_router_w': nrm(ks[20], (N_ODD, D, N_EXPERTS), D ** -0.5),
        'moe_router_b': nrm(ks[21], (N_ODD, N_EXPERTS), 0.01),
        'moe_w_gate_up': nrm(ks[22], (N_ODD, N_EXPERTS, D, 2 * D_FF_EXPERT), D ** -0.5),
        'moe_w_down': nrm(ks[23], (N_ODD, N_EXPERTS, D_FF_EXPERT, D), D_FF_EXPERT ** -0.5),
    }


def reference(x, c, positions, ada_w, ada_b, norm_g,
              gmlp_w_in, gmlp_b_in, gmlp_ln_g, gmlp_ln_b, gmlp_w_s, gmlp_b_s, gmlp_w_out,
              attn_w_qkv, attn_q_norm_g, attn_k_norm_g, attn_sinks, attn_w_o,
              ffn_w_gate_up, ffn_w_down,
              moe_router_w, moe_router_b, moe_w_gate_up, moe_w_down):
    sc = jax.nn.silu(c)
    inv_freq = ROPE_THETA ** (-jnp.arange(0, ROT_DIM, 2, dtype=jnp.float32) / ROT_DIM)
    ang = positions.astype(jnp.float32)[..., None] * inv_freq
    cos = jnp.cos(ang)[:, :, None, :].astype(x.dtype)
    sin = jnp.sin(ang)[:, :, None, :].astype(x.dtype)

    for i in range(DEPTH):
        j = i // 2
        mod = (sc @ ada_w[i] + ada_b[i])[:, None, :]
        sh1, sc1, g1, sh2, sc2, g2 = jnp.split(mod, 6, axis=-1)

        h = _rms(x, norm_g[i, 0]) * (1.0 + sc1) + sh1
        if i % N_TOKEN_MIXERS == 0:
            y = _gmlp_mixer(h, gmlp_w_in[j], gmlp_b_in[j], gmlp_ln_g[j], gmlp_ln_b[j],
                            gmlp_w_s[j], gmlp_b_s[j], gmlp_w_out[j])
        else:
            y = _swa_sink_attention(h, attn_w_qkv[j], attn_q_norm_g[j], attn_k_norm_g[j],
                                    attn_sinks[j], attn_w_o[j], cos, sin)
        x = x + g1 * y

        h = _rms(x, norm_g[i, 1]) * (1.0 + sc2) + sh2
        if i % 2 == 0:
            y = _swiglu(h, ffn_w_gate_up[j], ffn_w_down[j])
        else:
            y = _moe(h, moe_router_w[j], moe_router_b[j], moe_w_gate_up[j], moe_w_down[j])
        x = x + g2 * y
    return x
```

```cpp
#include <hip/hip_runtime.h>
#include <cstdio>
#include <cstdint>

#ifndef MK_PER_PHASE
#define MK_PER_PHASE 0
#endif

#ifndef PROBE_DUP
#define PROBE_DUP -1
#endif
#define GAS __attribute__((address_space(1)))
#define LAS __attribute__((address_space(3)))
typedef unsigned short bf16;
typedef short bf16x8 __attribute__((ext_vector_type(8)));
typedef short s16x4 __attribute__((ext_vector_type(4)));
typedef float f32x4 __attribute__((ext_vector_type(4)));
typedef float f32x2 __attribute__((ext_vector_type(2)));
typedef unsigned u32x4 __attribute__((ext_vector_type(4)));
typedef unsigned u32x2 __attribute__((ext_vector_type(2)));
typedef int i32x4 __attribute__((ext_vector_type(4)));
typedef int i32x8 __attribute__((ext_vector_type(8)));

constexpr int D = 2048, NB = 4, SEQ = 4096, M = NB * SEQ;
constexpr int GW = 4096, NIN = 2 * GW;
constexpr int FF = 5632, FFE = 7168, NE = 8;
constexpr int NQKV = 2560, HD = 64;
constexpr int SLOTS = 2 * M + NE * 256;
constexpr float EPS = 1e-6f;

constexpr size_t MiB = 1u << 20;
constexpr size_t WS_CTL = 0, CTL_ZERO_BYTES = 1 * MiB;
constexpr size_t WS_MOD = 1 * MiB;
constexpr size_t WS_CS = 2 * MiB;
constexpr size_t WS_WSB = 3 * MiB;
constexpr size_t WS_TOKE = 4 * MiB;
constexpr size_t WS_TOKW = WS_TOKE + 64 * 1024;
constexpr size_t WS_SLOT = WS_TOKW + 128 * 1024;
constexpr size_t WS_TOKOF = 5 * MiB;
constexpr size_t WS_VST = 8 * MiB;
constexpr size_t WS_WIN = 16 * MiB, WS_WOUT = 48 * MiB, WS_WGU = 64 * MiB, WS_WD = 108 * MiB, WS_WQKV = 130 * MiB, WS_WO = 140 * MiB;
constexpr size_t WS_MWGU = 148 * MiB, WS_MWD = 596 * MiB;
constexpr size_t WS_H = 820 * MiB, WS_U = 884 * MiB, WS_V = 1012 * MiB, WS_FFH = 1140 * MiB, WS_Q = 1316 * MiB, WS_KB = 1380 * MiB, WS_VB = 1388 * MiB;
constexpr size_t WS_XB = 1396 * MiB;
constexpr size_t WS_AS = 1396 * MiB, WS_HID = 1532 * MiB, WS_OE = 2008 * MiB, WS_TP = 2144 * MiB, WS_END = 2208 * MiB;
constexpr int MAIN_TILES = 2 * M / 256, TAIL_KSPLIT = 4, TAIL_ROWS = NE * 256;
static_assert(WS_AS + (size_t)SLOTS * D * 2 <= WS_HID && WS_HID + (size_t)SLOTS * FFE * 2 <= WS_OE && WS_OE + (size_t)SLOTS * D * 2 <= WS_TP && WS_TP + (size_t)TAIL_KSPLIT * TAIL_ROWS * D * 4 <= WS_END, "ws map");
static_assert(WS_FFH + (size_t)M * FF * 2 <= WS_Q && WS_MWGU + (size_t)NE * 2 * FFE * D * 2 <= WS_MWD && WS_MWD + (size_t)NE * D * FFE * 2 <= WS_H, "ws map");
constexpr int CW_BAR = 4096;
constexpr int CW_CNT = 16384;
constexpr int CW_META = 16384 + 2048;

constexpr int RING_BYTES = 131072;
constexpr int MISC_OFF = RING_BYTES;
constexpr int LDS_BYTES = 147456;
constexpr int NWAVES = 8, NTHR = 512;

#define RLX_AGENT __ATOMIC_RELAXED, __HIP_MEMORY_SCOPE_AGENT
#define LDS_WAIT() asm volatile("s_waitcnt lgkmcnt(0)" ::: "memory")
#define VM_WAIT() asm volatile("s_waitcnt vmcnt(0)" ::: "memory")
__device__ __forceinline__ unsigned f2bf(float f) { unsigned u = __builtin_bit_cast(unsigned, f); return (u + 0x7fffu + ((u >> 16) & 1u)) >> 16; }
__device__ __forceinline__ unsigned pk2(float lo, float hi) { return f2bf(lo) | (f2bf(hi) << 16); }
__device__ __forceinline__ float bf2f(unsigned short b) { return __builtin_bit_cast(float, (unsigned)b << 16); }
__device__ __forceinline__ float bflo(unsigned w) { return __builtin_bit_cast(float, w << 16); }
__device__ __forceinline__ float bfhi(unsigned w) { return __builtin_bit_cast(float, w & 0xffff0000u); }
__device__ __forceinline__ unsigned cvt_pk_bf16(float lo, float hi) { unsigned r; asm volatile("v_cvt_pk_bf16_f32 %0, %1, %2" : "=v"(r) : "v"(lo), "v"(hi)); return r; }
__device__ __forceinline__ float wave_sum(float v) {
#pragma unroll
    for (int o = 1; o < 64; o <<= 1) v += __shfl_xor(v, o);
    return v;
}
__device__ __forceinline__ float fast_exp2(float x) { return __builtin_amdgcn_exp2f(x); }
__device__ __forceinline__ float fast_rcp(float x) { return __builtin_amdgcn_rcpf(x); }
__device__ __forceinline__ unsigned pk4_fp8(float a, float b, float c, float d) {
    a = __builtin_amdgcn_fmed3f(a, -448.f, 448.f); b = __builtin_amdgcn_fmed3f(b, -448.f, 448.f); c = __builtin_amdgcn_fmed3f(c, -448.f, 448.f); d = __builtin_amdgcn_fmed3f(d, -448.f, 448.f);
    unsigned w = 0; w = __builtin_amdgcn_cvt_pk_fp8_f32(a, b, w, false); w = __builtin_amdgcn_cvt_pk_fp8_f32(c, d, w, true); return w;
}
constexpr float SC_H = 16.f, SC_W = 512.f, SC_HID = 4.f;
__device__ __forceinline__ float silu_f(float g) { return g * fast_rcp(1.0f + fast_exp2(-1.44269504089f * g)); }

#define XB_TMO      128
#define XB_XCNT(j)  (256  + 64 * (j))
#define XB_XSUB(j)  (1280 + 64 * (j))
#define XB_XGEN(j)  (2304 + 64 * (j))
#define XB_TOP      3328
#define XB_TOPGEN   3392
#define XCD_BAR_WORDS 3456
#define XB_SPIN_CAP (1u << 18)
__device__ __forceinline__ unsigned xb_ld(unsigned* p)              { return __hip_atomic_load(p, __ATOMIC_RELAXED, __HIP_MEMORY_SCOPE_AGENT); }
__device__ __forceinline__ unsigned xb_add(unsigned* p, unsigned v) { return __hip_atomic_fetch_add(p, v, __ATOMIC_RELAXED, __HIP_MEMORY_SCOPE_AGENT); }
__device__ __forceinline__ unsigned xb_xcc_id() { return (unsigned)__builtin_amdgcn_s_getreg((3 << 11) | 20) & 0xFu; }
#define XB_SPIN(cond, bar) do { unsigned _sp = 0; while (cond) { __builtin_amdgcn_s_sleep(1); \
    if ((++_sp & 255u) == 0u) { if (xb_ld(&(bar)[XB_TMO])) break; if (_sp > XB_SPIN_CAP) { atomicAdd(&(bar)[XB_TMO], 1u); break; } } } } while (0)
struct XcdBarrier { unsigned* bar; unsigned x; volatile LAS unsigned* st; };
__device__ __forceinline__ XcdBarrier xcd_barrier_post(unsigned* bar, volatile LAS unsigned* st) {
    XcdBarrier b; b.bar = bar; b.x = xb_xcc_id(); b.st = st;
    if (threadIdx.x == 0) (void)xb_add(&bar[XB_XCNT(b.x)], 1u);
    return b;
}
__device__ __forceinline__ void xcd_barrier_complete(unsigned* bar, unsigned x, unsigned& nloc, unsigned& nx) {
    const unsigned G = gridDim.x * gridDim.y * gridDim.z;
    unsigned sum, cnt, mine, sp = 0u;
    for (;;) {
        sum = 0u; cnt = 0u; mine = 0u;
#pragma unroll
        for (unsigned j = 0; j < 16; ++j) { const unsigned c = xb_ld(&bar[XB_XCNT(j)]); sum += c; cnt += (c > 0u) ? 1u : 0u; mine = (j == x) ? c : mine; }
        if (sum == G) break;
        __builtin_amdgcn_s_sleep(1);
        if ((++sp & 255u) == 0u) { if (xb_ld(&bar[XB_TMO])) break; if (sp > XB_SPIN_CAP) { atomicAdd(&bar[XB_TMO], 1u); break; } }
    }
    nloc = mine > 0u ? mine : 1u; nx = cnt > 0u ? cnt : 1u;
}
__device__ __forceinline__ void xcd_barrier(const XcdBarrier& b) {
    asm volatile("s_waitcnt vmcnt(0)" ::: "memory");
    __syncthreads();
    if (threadIdx.x == 0) {
        unsigned* bar = b.bar;
        __builtin_amdgcn_s_waitcnt(0);
        unsigned nloc = b.st[0], nx = b.st[1];
        if (nloc == 0u) { xcd_barrier_complete(bar, b.x, nloc, nx); b.st[0] = nloc; b.st[1] = nx; }
        const unsigned old = xb_add(&bar[XB_XSUB(b.x)], 1u);
        const unsigned gen = old / nloc;
        if (old + 1u == (gen + 1u) * nloc) {
            __builtin_amdgcn_fence(__ATOMIC_RELEASE, "agent");
            asm volatile("s_waitcnt vmcnt(0)" ::: "memory");
            const unsigned og = xb_add(&bar[XB_TOP], 1u);
            const unsigned tg = og / nx;
            if (og + 1u == (tg + 1u) * nx) xb_add(&bar[XB_TOPGEN], 1u);
            else XB_SPIN(xb_ld(&bar[XB_TOPGEN]) == tg, bar);
            __builtin_amdgcn_fence(__ATOMIC_ACQUIRE, "agent");
            xb_add(&bar[XB_XGEN(b.x)], 1u);
            asm volatile("s_waitcnt vmcnt(0)" ::: "memory");
        } else {
            XB_SPIN(xb_ld(&bar[XB_XGEN(b.x)]) == gen, bar);
            __builtin_amdgcn_fence(__ATOMIC_ACQUIRE, "agent");
            asm volatile("s_waitcnt vmcnt(0)" ::: "memory");
        }
    }
    __syncthreads();
}

namespace pg8 {
constexpr int BM = 256, BK = 64, HALF = 128, HTB = HALF * BK * 2, STAGE_BYTES = 8 * HTB, NXCD = 8, WGM = 8;
__host__ __device__ __forceinline__ int lds_byte(int r, int c) { const int st = (r >> 4) * 2 + (c >> 5), rr = r & 15, cc = c & 31, ob = rr * 64 + cc * 2; return st * 1024 + (ob ^ (((ob >> 9) & 1) << 5)); }
__host__ __device__ __forceinline__ void stage_rc(int b, int& R, int& C) { const int st = b / 1024, sb = b % 1024, swz = sb ^ (((sb >> 9) & 1) << 5); R = (st >> 1) * 16 + swz / 64; C = (st & 1) * 32 + (swz % 64) / 2; }
__host__ __device__ __forceinline__ int perm32(int rho) { const int n = rho >> 4, i = rho & 15; return 8 * (i >> 2) + 4 * n + (i & 3); }

struct Unit { int pm, pn, eb, koff; };
struct Gemm { const void* A; const void* Bt; int rowbytes; size_t bstride; int ktiles; const unsigned* rowoff; };

struct Order {
    int nM, nN, nwg, G, c; const volatile LAS int* tb; int ksplit, kbytes, pm0;
    __device__ void init(int nM_, int nN_, int G_, int c_, const volatile LAS int* tb_) { nM = nM_; nN = nN_; nwg = nM * nN; G = G_; c = c_; tb = tb_; ksplit = 0; kbytes = 0; pm0 = 0; }
    __device__ void init_tail(int pm0_, int nMt, int nN_, int ksplit_, int kbytes_, int G_, int c_, const volatile LAS int* tb_) { nM = nMt; nN = nN_; nwg = nMt * nN_ * ksplit_; G = G_; c = c_; tb = tb_; ksplit = ksplit_; kbytes = kbytes_; pm0 = pm0_; }
    __device__ bool next(int i, Unit& u) const {
        const long L = (long)i * G + c; if (L >= nwg) return false;
        u.eb = 0; u.koff = 0;
        if (ksplit) { u.pm = pm0 + (int)(L / (nN * ksplit)); const int rem = (int)(L % (nN * ksplit)); u.pn = rem / ksplit; u.koff = (rem % ksplit) * kbytes; }
        else {
            int wgid = (int)L; { const int q = nwg / NXCD, r = nwg % NXCD, xcd = wgid % NXCD, off = wgid / NXCD; wgid = (xcd < r ? xcd * (q + 1) : r * (q + 1) + (xcd - r) * q) + off; }
            const int nig = WGM * nN, gid = wgid / nig, fm = gid * WGM, gsz = (nM - fm) < WGM ? (nM - fm) : WGM;
            u.pm = fm + ((wgid % nig) % gsz); u.pn = (wgid % nig) / gsz; }
        if (tb) { int e = 0;
#pragma unroll
            for (int j = 1; j < 8; ++j) e += (u.pm >= __builtin_amdgcn_readfirstlane(tb[j])) ? 1 : 0;
            u.eb = e; }
        return true;
    }
};

__device__ __forceinline__ f32x2 gelu_pk(f32x2 v) {
    const f32x2 av = __builtin_elementwise_abs(v), d = av * 0.2316418882f + 1.0f;
    f32x2 t; t.x = __builtin_amdgcn_rcpf(d.x); t.y = __builtin_amdgcn_rcpf(d.y);
    f32x2 q = t * 0.5307027145f + (-0.7265760135f); q = q * t + 0.7107068705f; q = q * t + (-0.142248368f); q = q * t + 0.127414796f; q = q * t;
    const f32x2 s = (v * v) * (-0.72134752044f);
    f32x2 e; e.x = __builtin_amdgcn_exp2f(s.x); e.y = __builtin_amdgcn_exp2f(s.y);
    const f32x2 m = v * (q * e), r = v - m;
    f32x2 o; o.x = v.x < 0.f ? m.x : r.x; o.y = v.y < 0.f ? m.y : r.y; return o;
}


struct EpiGelu {
    static constexpr bool PERM = true; static constexpr int NST = 16;
    bf16* U; bf16* V; const float* bias; f32x2* vst;
    __device__ __forceinline__ void operator()(const f32x4 (&acc)[2][2][4][2], const Unit& u, int wr, int wc, int fr, int fq) const {
        const bool isv = u.pn >= 16; bf16* base = isv ? V : U; const int colt = (u.pn & 15) * BM;
        const int row0 = u.pm * BM + wr * 64 + fr, col0 = colt + wc * 32 + 8 * fq, bcol0 = u.pn * BM + wc * 32 + 8 * fq;
        f32x4 bv[2][2];
#pragma unroll
        for (int bj = 0; bj < 2; ++bj)
#pragma unroll
            for (int n = 0; n < 2; ++n) bv[bj][n] = *(const f32x4*)(bias + bcol0 + bj * HALF + 4 * n);
#pragma unroll
        for (int ai = 0; ai < 2; ++ai)
#pragma unroll
            for (int m = 0; m < 4; ++m) { const int row = row0 + ai * HALF + m * 16; bf16* rowp = base + (size_t)row * GW + col0; float s = 0.f, q = 0.f;
#pragma unroll
                for (int bj = 0; bj < 2; ++bj) { f32x4 v0 = acc[ai][bj][m][0] + bv[bj][0], v1 = acc[ai][bj][m][1] + bv[bj][1];
                    { f32x2 a = gelu_pk((f32x2){v0[0], v0[1]}), b = gelu_pk((f32x2){v0[2], v0[3]}), c = gelu_pk((f32x2){v1[0], v1[1]}), d = gelu_pk((f32x2){v1[2], v1[3]});
                      v0 = (f32x4){a.x, a.y, b.x, b.y}; v1 = (f32x4){c.x, c.y, d.x, d.y}; }
                    s += (v0[0] + v0[1]) + (v0[2] + v0[3]) + (v1[0] + v1[1]) + (v1[2] + v1[3]);
                    q += (v0[0] * v0[0] + v0[1] * v0[1]) + (v0[2] * v0[2] + v0[3] * v0[3]) + (v1[0] * v1[0] + v1[1] * v1[1]) + (v1[2] * v1[2] + v1[3] * v1[3]);
                    u32x4 w; w.x = cvt_pk_bf16(v0[0], v0[1]); w.y = cvt_pk_bf16(v0[2], v0[3]); w.z = cvt_pk_bf16(v1[0], v1[1]); w.w = cvt_pk_bf16(v1[2], v1[3]);
                    *(u32x4*)(rowp + bj * HALF) = w; }
                if (isv) { s += __shfl_xor(s, 16); s += __shfl_xor(s, 32); q += __shfl_xor(q, 16); q += __shfl_xor(q, 32);
                    if (fq == 0) vst[(size_t)row * 64 + (u.pn - 16) * 4 + wc] = (f32x2){s, q}; } }
    }
};
struct EpiRes {
    static constexpr bool PERM = false; static constexpr int NST = 32;
    const float* base; float* out; const float* gate; float sc;
    __device__ __forceinline__ void operator()(const f32x4 (&acc)[2][2][4][2], const Unit& u, int wr, int wc, int fr, int fq) const {
        const int row0 = u.pm * BM + wr * 64 + fr, col0 = u.pn * BM + wc * 32 + 4 * fq; const float* gp = gate + (size_t)((u.pm * BM) / SEQ) * (6 * D) + col0;
        f32x4 gv[2][2];
#pragma unroll
        for (int bj = 0; bj < 2; ++bj)
#pragma unroll
            for (int n = 0; n < 2; ++n) gv[bj][n] = *(const f32x4*)(gp + bj * HALF + n * 16) * sc;
#pragma unroll
        for (int ai = 0; ai < 2; ++ai)
#pragma unroll
            for (int m = 0; m < 4; ++m) { const size_t off = (size_t)(row0 + ai * HALF + m * 16) * D + col0;
#pragma unroll
                for (int bj = 0; bj < 2; ++bj)
#pragma unroll
                    for (int n = 0; n < 2; ++n) { const f32x4 b = *(const f32x4*)(base + off + bj * HALF + n * 16); *(f32x4*)(out + off + bj * HALF + n * 16) = b + gv[bj][n] * acc[ai][bj][m][n]; } }
    }
};
template <bool B32>
struct EpiResB {
    static constexpr bool PERM = true; static constexpr int NST = 16;
    const float* base32; bf16* xb; const float* gate; float sc;
    __device__ __forceinline__ void operator()(const f32x4 (&acc)[2][2][4][2], const Unit& u, int wr, int wc, int fr, int fq) const {
        const int row0 = u.pm * BM + wr * 64 + fr, col0 = u.pn * BM + wc * 32 + 8 * fq; const float* gp = gate + (size_t)((u.pm * BM) / SEQ) * (6 * D) + col0;
        f32x4 gv[2][2];
#pragma unroll
        for (int bj = 0; bj < 2; ++bj)
#pragma unroll
            for (int n = 0; n < 2; ++n) gv[bj][n] = *(const f32x4*)(gp + bj * HALF + 4 * n) * sc;
#pragma unroll
        for (int ai = 0; ai < 2; ++ai)
#pragma unroll
            for (int m = 0; m < 4; ++m) { const size_t off = (size_t)(row0 + ai * HALF + m * 16) * D + col0;
#pragma unroll
                for (int bj = 0; bj < 2; ++bj) { f32x4 b0, b1;
                    if constexpr (B32) { b0 = *(const f32x4*)(base32 + off + bj * HALF); b1 = *(const f32x4*)(base32 + off + bj * HALF + 4); }
                    else { const u32x4 x = *(const u32x4*)(xb + off + bj * HALF); b0 = (f32x4){bflo(x.x), bfhi(x.x), bflo(x.y), bfhi(x.y)}; b1 = (f32x4){bflo(x.z), bfhi(x.z), bflo(x.w), bfhi(x.w)}; }
                    const f32x4 r0 = b0 + gv[bj][0] * acc[ai][bj][m][0], r1 = b1 + gv[bj][1] * acc[ai][bj][m][1];
                    u32x4 o; o.x = cvt_pk_bf16(r0[0], r0[1]); o.y = cvt_pk_bf16(r0[2], r0[3]); o.z = cvt_pk_bf16(r1[0], r1[1]); o.w = cvt_pk_bf16(r1[2], r1[3]);
                    *(u32x4*)(xb + off + bj * HALF) = o; } }
    }
};
struct EpiSwiglu {
    static constexpr bool PERM = true; static constexpr int NST = 8;
    bf16* Hh; int ldc;
    __device__ __forceinline__ void operator()(const f32x4 (&acc)[2][2][4][2], const Unit& u, int wr, int wc, int fr, int fq) const {
        const int row0 = u.pm * BM + wr * 64 + fr, col0 = u.pn * HALF + wc * 32 + 8 * fq;
#pragma unroll
        for (int ai = 0; ai < 2; ++ai)
#pragma unroll
            for (int m = 0; m < 4; ++m) { bf16* rowp = Hh + (size_t)(row0 + ai * HALF + m * 16) * ldc + col0;
                const f32x4 g0 = acc[ai][0][m][0], g1 = acc[ai][0][m][1], u0 = acc[ai][1][m][0], u1 = acc[ai][1][m][1];
                u32x4 w; w.x = cvt_pk_bf16(silu_f(g0[0]) * u0[0], silu_f(g0[1]) * u0[1]); w.y = cvt_pk_bf16(silu_f(g0[2]) * u0[2], silu_f(g0[3]) * u0[3]);
                w.z = cvt_pk_bf16(silu_f(g1[0]) * u1[0], silu_f(g1[1]) * u1[1]); w.w = cvt_pk_bf16(silu_f(g1[2]) * u1[2], silu_f(g1[3]) * u1[3]);
                *(u32x4*)rowp = w; }
    }
};
struct EpiBf16 {
    static constexpr bool PERM = true; static constexpr int NST = 16;
    bf16* O; int ldc; float sc;
    __device__ __forceinline__ void operator()(const f32x4 (&acc)[2][2][4][2], const Unit& u, int wr, int wc, int fr, int fq) const {
        const int row0 = u.pm * BM + wr * 64 + fr, col0 = u.pn * BM + wc * 32 + 8 * fq;
#pragma unroll
        for (int ai = 0; ai < 2; ++ai)
#pragma unroll
            for (int m = 0; m < 4; ++m) { bf16* rowp = O + (size_t)(row0 + ai * HALF + m * 16) * ldc + col0;
#pragma unroll
                for (int bj = 0; bj < 2; ++bj) { const f32x4 v0 = acc[ai][bj][m][0] * sc, v1 = acc[ai][bj][m][1] * sc;
                    u32x4 w; w.x = cvt_pk_bf16(v0[0], v0[1]); w.y = cvt_pk_bf16(v0[2], v0[3]); w.z = cvt_pk_bf16(v1[0], v1[1]); w.w = cvt_pk_bf16(v1[2], v1[3]);
                    *(u32x4*)(rowp + bj * HALF) = w; } }
    }
};
struct EpiSwiglu8 {
    static constexpr bool PERM = true; static constexpr int NST = 8;
    unsigned char* Hh; int ldc; float isc, osc;
    __device__ __forceinline__ void operator()(const f32x4 (&acc)[2][2][4][2], const Unit& u, int wr, int wc, int fr, int fq) const {
        const int row0 = u.pm * BM + wr * 64 + fr, col0 = u.pn * HALF + wc * 32 + 8 * fq;
#pragma unroll
        for (int ai = 0; ai < 2; ++ai)
#pragma unroll
            for (int m = 0; m < 4; ++m) { unsigned char* rowp = Hh + (size_t)(row0 + ai * HALF + m * 16) * ldc + col0;
                const f32x4 g0 = acc[ai][0][m][0] * isc, g1 = acc[ai][0][m][1] * isc, u0 = acc[ai][1][m][0] * (isc * osc), u1 = acc[ai][1][m][1] * (isc * osc);
                u32x2 w; w.x = pk4_fp8(silu_f(g0[0]) * u0[0], silu_f(g0[1]) * u0[1], silu_f(g0[2]) * u0[2], silu_f(g0[3]) * u0[3]);
                w.y = pk4_fp8(silu_f(g1[0]) * u1[0], silu_f(g1[1]) * u1[1], silu_f(g1[2]) * u1[2], silu_f(g1[3]) * u1[3]);
                *(u32x2*)rowp = w; }
    }
};
struct EpiPart {
    static constexpr bool PERM = false; static constexpr int NST = 32;
    float* P; int row_base, nrows, kbytes; float sc;
    __device__ __forceinline__ void operator()(const f32x4 (&acc)[2][2][4][2], const Unit& u, int wr, int wc, int fr, int fq) const {
        const int row0 = u.pm * BM - row_base + wr * 64 + fr, col0 = u.pn * BM + wc * 32 + 4 * fq; float* base = P + (size_t)(u.koff / kbytes) * nrows * D;
#pragma unroll
        for (int ai = 0; ai < 2; ++ai)
#pragma unroll
            for (int m = 0; m < 4; ++m) { float* rowp = base + (size_t)(row0 + ai * HALF + m * 16) * D + col0;
#pragma unroll
                for (int bj = 0; bj < 2; ++bj)
#pragma unroll
                    for (int n = 0; n < 2; ++n) *(f32x4*)(rowp + bj * HALF + n * 16) = acc[ai][bj][m][n] * sc; }
    }
};
struct EpiQKV {
    static constexpr bool PERM = true; static constexpr int NST = 16;
    bf16* Q; bf16* Kb; bf16* Vb; const float* qg; const float* kg; const float* cs;
    __device__ __forceinline__ void operator()(const f32x4 (&acc)[2][2][4][2], const Unit& u, int wr, int wc, int fr, int fq) const {
        const int row0 = u.pm * BM + wr * 64 + fr; const int t = u.pn;
        bf16* base; int ld; const float* gn; float osc;
        if (t < 8) { base = Q + (size_t)(4 * t + wc) * HD; ld = D; gn = qg; osc = 0.125f; } else if (t == 8) { base = Kb + wc * HD; ld = 4 * HD; gn = kg; osc = 1.f; } else { base = Vb + wc * HD; ld = 4 * HD; gn = kg; osc = 1.f; }
        f32x4 gv[2][2];
#pragma unroll
        for (int bj = 0; bj < 2; ++bj)
#pragma unroll
            for (int n = 0; n < 2; ++n) gv[bj][n] = *(const f32x4*)(gn + 32 * bj + 8 * fq + 4 * n);
#pragma unroll
        for (int ai = 0; ai < 2; ++ai)
#pragma unroll
            for (int m = 0; m < 4; ++m) { const int row = row0 + ai * HALF + m * 16; bf16* rowp = base + (size_t)row * ld + 8 * fq;
                f32x4 v[2][2];
#pragma unroll
                for (int bj = 0; bj < 2; ++bj)
#pragma unroll
                    for (int n = 0; n < 2; ++n) v[bj][n] = acc[ai][bj][m][n];
                if (t < 9) {
                    float ss = 0.f;
#pragma unroll
                    for (int bj = 0; bj < 2; ++bj)
#pragma unroll
                        for (int n = 0; n < 2; ++n) ss += (v[bj][n][0] * v[bj][n][0] + v[bj][n][1] * v[bj][n][1]) + (v[bj][n][2] * v[bj][n][2] + v[bj][n][3] * v[bj][n][3]);
                    ss += __shfl_xor(ss, 16); ss += __shfl_xor(ss, 32);
                    const float r = __builtin_amdgcn_rsqf(ss * (1.0f / HD) + EPS);
#pragma unroll
                    for (int bj = 0; bj < 2; ++bj)
#pragma unroll
                        for (int n = 0; n < 2; ++n) v[bj][n] = v[bj][n] * r * gv[bj][n];
                    const float* csr = cs + (size_t)row * 16;
#pragma unroll
                    for (int n = 0; n < 2; ++n) { f32x4 cv = (f32x4){1.f, 1.f, 1.f, 1.f}, sv = (f32x4){0.f, 0.f, 0.f, 0.f};
                        if (fq < 2) { cv = *(const f32x4*)(csr + 4 * n); sv = *(const f32x4*)(csr + 8 + 4 * n); }
                        f32x4 o;
#pragma unroll
                        for (int j = 0; j < 4; ++j) o[j] = __shfl_xor(v[0][n][j], 16);
                        if (fq == 0) v[0][n] = v[0][n] * cv - o * sv; else if (fq == 1) v[0][n] = v[0][n] * cv + o * sv; }
                }
#pragma unroll
                for (int bj = 0; bj < 2; ++bj) { const f32x4 v0 = v[bj][0] * osc, v1 = v[bj][1] * osc;
                    u32x4 w; w.x = cvt_pk_bf16(v0[0], v0[1]); w.y = cvt_pk_bf16(v0[2], v0[3]); w.z = cvt_pk_bf16(v1[0], v1[1]); w.w = cvt_pk_bf16(v1[2], v1[3]);
                    *(u32x4*)(rowp + 32 * bj) = w; } }
    }
};

#ifndef PG8_ALIGN
#define PG8_ALIGN true
#endif
template <class Epi, bool F8 = false, bool ALIGN_EPI = PG8_ALIGN, bool GATH = false>
__device__ __forceinline__ void gemm_phase(LAS unsigned char* lds, const Gemm g, const Order& S, const Epi& E) {
    const int tid = threadIdx.x, wid = __builtin_amdgcn_readfirstlane(tid >> 6), lane = tid & 63, wr = wid >> 2, wc = wid & 3, fr = lane & 15, fq = lane >> 4;
    const int RB = g.rowbytes, nt = g.ktiles ? g.ktiles : RB / 128;
    unsigned voffA[2], voffB[2];
#pragma unroll
    for (int i = 0; i < 2; ++i) { int R, C; stage_rc(tid * 16 + i * 8192, R, C); const int Rb = Epi::PERM ? ((R & ~31) + perm32(R & 31)) : R;
        voffA[i] = (unsigned)(R * RB + C * 2); voffB[i] = (unsigned)(Rb * RB + C * 2); }
    unsigned gA[2], gN[2]; int gR0; unsigned gCb; { int R_, C_; stage_rc(tid * 16, R_, C_); gR0 = R_; gCb = (unsigned)(C_ * 2); }
    const size_t kstep = (size_t)(BK * 2);
    const size_t hstep = (size_t)HALF * RB;
    const size_t tstep = 2 * hstep;
    const unsigned ldsw = (unsigned)wid * 1024u;
    const int aoff = lds_byte(wr * 64 + fr, fq * 8), boff = lds_byte(wc * 32 + fr, fq * 8);
#define PG8_SA(b, h) (((b) * 2 + (h)) * HTB)
#define PG8_SB(b, h) ((4 + (b) * 2 + (h)) * HTB)
#define PG8_STAGE(bufoff, gbase, voff) do { _Pragma("unroll") for (int _i = 0; _i < 2; ++_i) \
        __builtin_amdgcn_global_load_lds((const unsigned*)((const char*)(gbase) + (voff)[_i]), (LAS unsigned*)(lds + (bufoff) + ldsw + _i * 8192), 16, 0, 0); } while (0)
#define PG8_STAGE_A(bufoff, gbase, h_, nx_) do { _Pragma("unroll") for (int _i = 0; _i < 2; ++_i) { \
        const unsigned o_ = GATH ? ((((nx_) ? gN[h_] : gA[h_]) >> (16 * _i)) & 0xffffu) * (unsigned)RB + gCb : voffA[_i]; const char* b_ = GATH ? (const char*)(gbase) : (const char*)(gbase) + ((h_) ? hstep : 0); \
        __builtin_amdgcn_global_load_lds((const unsigned*)(b_ + o_), (LAS unsigned*)(lds + (bufoff) + ldsw + _i * 8192), 16, 0, 0); } } while (0)
#define PG8_GLOAD(dst_, pm_) do { _Pragma("unroll") for (int h_ = 0; h_ < 2; ++h_) dst_[h_] = g.rowoff[(pm_) * BM + h_ * HALF + gR0] | (g.rowoff[(pm_) * BM + h_ * HALF + gR0 + 64] << 16); } while (0)
#define PG8_RD(off) (*(const LAS bf16x8*)(lds + (off)))
#define PG8_LDA(dst, b, h) do { _Pragma("unroll") for (int m = 0; m < 4; ++m) { if constexpr (F8) dst##8[m] = PG8_CAT(PG8_RD(PG8_SA(b, h) + aoff + m * 2048), PG8_RD(PG8_SA(b, h) + aoff + m * 2048 + 1024)); \
        else { dst[m][0] = PG8_RD(PG8_SA(b, h) + aoff + m * 2048); dst[m][1] = PG8_RD(PG8_SA(b, h) + aoff + m * 2048 + 1024); } } } while (0)
#define PG8_LDB(dst, b, h) do { _Pragma("unroll") for (int n = 0; n < 2; ++n) { if constexpr (F8) dst##8[n] = PG8_CAT(PG8_RD(PG8_SB(b, h) + boff + n * 2048), PG8_RD(PG8_SB(b, h) + boff + n * 2048 + 1024)); \
        else { dst[n][0] = PG8_RD(PG8_SB(b, h) + boff + n * 2048); dst[n][1] = PG8_RD(PG8_SB(b, h) + boff + n * 2048 + 1024); } } } while (0)
#define PG8_MMA(ai, bj, At, Bt) do { __builtin_amdgcn_s_setprio(1); _Pragma("unroll") for (int m = 0; m < 4; ++m) _Pragma("unroll") for (int n = 0; n < 2; ++n) { \
        if constexpr (F8) { asm volatile("v_mfma_f32_16x16x128_f8f6f4 %0, %1, %2, %0" : "+v"(acc[ai][bj][m][n]) : "v"(Bt##8[n]), "v"(At##8[m])); } \
        else { _Pragma("unroll") for (int k = 0; k < 2; ++k) acc[ai][bj][m][n] = __builtin_amdgcn_mfma_f32_16x16x32_bf16(Bt[n][k], At[m][k], acc[ai][bj][m][n], 0, 0, 0); } } \
        __builtin_amdgcn_s_setprio(0); } while (0)
#define PG8_CAT(x, y) __builtin_shufflevector(__builtin_bit_cast(i32x4, x), __builtin_bit_cast(i32x4, y), 0, 1, 2, 3, 4, 5, 6, 7)
#define PG8_WAIT_V(n) asm volatile("s_waitcnt vmcnt(" #n ")" ::: "memory")
#define PG8_WAIT_VN(n) asm volatile("s_waitcnt vmcnt(%0)" :: "n"(n) : "memory")
#define PG8_WAIT_L(n) asm volatile("s_waitcnt lgkmcnt(" #n ")" ::: "memory")
#define PG8_BAR __builtin_amdgcn_s_barrier()
#define PG8_SCHED __builtin_amdgcn_sched_barrier(0)
    Unit cur, nxt; int ui = 0;
    if (!S.next(0, cur)) return;
    f32x4 acc[2][2][4][2];
#pragma unroll
    for (int a = 0; a < 2; ++a)
#pragma unroll
        for (int b = 0; b < 2; ++b)
#pragma unroll
            for (int m = 0; m < 4; ++m)
#pragma unroll
                for (int n = 0; n < 2; ++n) acc[a][b][m][n] = (f32x4){0.f, 0.f, 0.f, 0.f};
    bf16x8 At[4][2], B0[2][2], B1[2][2]; i32x8 At8[4], B08[2], B18[2];
    const char* cA = (const char*)g.A + (GATH ? (size_t)0 : (size_t)cur.pm * tstep) + cur.koff;
    if constexpr (GATH) PG8_GLOAD(gA, cur.pm); const char* cB = (const char*)g.Bt + (size_t)cur.eb * g.bstride + (size_t)cur.pn * tstep + cur.koff;
    PG8_STAGE(PG8_SB(0, 0), cB, voffB); PG8_STAGE(PG8_SB(0, 1), cB + hstep, voffB); PG8_STAGE_A(PG8_SA(0, 0), cA, 0, false); PG8_STAGE_A(PG8_SA(0, 1), cA, 1, false);
    if (wr == 1) PG8_BAR;
    PG8_WAIT_V(2); PG8_BAR;
    PG8_STAGE(PG8_SB(1, 0), cB + kstep, voffB); PG8_STAGE_A(PG8_SA(1, 0), cA + kstep, 0, false); PG8_STAGE(PG8_SB(1, 1), cB + hstep + kstep, voffB);
    PG8_WAIT_V(6); PG8_BAR;
    for (;;) {
        const bool has_next = S.next(ui + 1, nxt);
        const char* nA = has_next ? (const char*)g.A + (GATH ? (size_t)0 : (size_t)nxt.pm * tstep) + nxt.koff : cA;
        if constexpr (GATH) { if (has_next) PG8_GLOAD(gN, nxt.pm); } const char* nB = has_next ? (const char*)g.Bt + (size_t)nxt.eb * g.bstride + (size_t)nxt.pn * tstep + nxt.koff : cB;
        for (int t = 0; t < nt; t += 2) {
            const bool last = (t == nt - 2); const bool nx = last && has_next;
            const char* a1 = cA + (size_t)(t + 1) * kstep;
            const char* a2 = last ? nA : cA + (size_t)(t + 2) * kstep; const char* b2 = last ? nB : cB + (size_t)(t + 2) * kstep;
            const char* a3 = a2 + kstep; const char* b3 = b2 + kstep;
            int tf_ = __builtin_amdgcn_readfirstlane(t | (ui > 0 ? 0 : 1)); asm volatile("" : "+s"(tf_));
            const bool fresh = tf_ == 0;
            PG8_LDB(B0, 0, 0); PG8_LDB(B1, 0, 1); PG8_SCHED; PG8_LDA(At, 0, 0); PG8_STAGE_A(PG8_SA(1, 1), a1, 1, false);
            if (fresh) PG8_WAIT_VN(8 + Epi::NST); else PG8_WAIT_V(8);
            PG8_WAIT_L(0); PG8_BAR; PG8_MMA(0, 0, At, B0); PG8_MMA(0, 1, At, B1); PG8_BAR; PG8_SCHED;
            PG8_LDA(At, 0, 1); PG8_STAGE(PG8_SB(0, 0), b2, voffB); PG8_STAGE(PG8_SB(0, 1), b2 + hstep, voffB); PG8_STAGE_A(PG8_SA(0, 0), a2, 0, nx);
            if (fresh) PG8_WAIT_VN(8 + Epi::NST); else PG8_WAIT_V(8);
            PG8_WAIT_L(0); PG8_BAR; PG8_MMA(1, 0, At, B0); PG8_MMA(1, 1, At, B1); PG8_BAR; PG8_SCHED;
            PG8_LDB(B0, 1, 0); PG8_LDB(B1, 1, 1); PG8_SCHED; PG8_LDA(At, 1, 0); PG8_STAGE_A(PG8_SA(0, 1), a2, 1, nx);
            PG8_WAIT_V(8); PG8_WAIT_L(0); PG8_BAR; PG8_MMA(0, 0, At, B0); PG8_MMA(0, 1, At, B1); PG8_BAR; PG8_SCHED;
            PG8_LDA(At, 1, 1); PG8_STAGE(PG8_SB(1, 0), b3, voffB); PG8_STAGE(PG8_SB(1, 1), b3 + hstep, voffB); PG8_STAGE_A(PG8_SA(1, 0), a3, 0, nx);
            PG8_WAIT_V(8); PG8_WAIT_L(0); PG8_BAR; PG8_MMA(1, 0, At, B0); PG8_MMA(1, 1, At, B1); PG8_BAR; PG8_SCHED;
        }
        if constexpr (F8) asm volatile("s_nop 15\n\ts_nop 15" ::: "memory");
        if constexpr (ALIGN_EPI) { if (wr == 0) PG8_BAR; }
        E(acc, cur, wr, wc, fr, fq);
        if (!has_next) break;
#pragma unroll
        for (int a = 0; a < 2; ++a)
#pragma unroll
            for (int b = 0; b < 2; ++b)
#pragma unroll
                for (int m = 0; m < 4; ++m)
#pragma unroll
                    for (int n = 0; n < 2; ++n) acc[a][b][m][n] = (f32x4){0.f, 0.f, 0.f, 0.f};
        cur = nxt; cA = nA; cB = nB; ++ui;
        if constexpr (GATH) { gA[0] = gN[0]; gA[1] = gN[1]; }
        if constexpr (ALIGN_EPI) { if (wr == 1) PG8_BAR; }
    }
    PG8_WAIT_V(0);
    if constexpr (!ALIGN_EPI) { if (wr == 0) PG8_BAR; }
    PG8_BAR;
#undef PG8_SA
#undef PG8_SB
#undef PG8_STAGE
#undef PG8_STAGE_A
#undef PG8_GLOAD
#undef PG8_LDA
#undef PG8_RD
#undef PG8_LDB
#undef PG8_MMA
#undef PG8_CAT
#undef PG8_WAIT_V
#undef PG8_WAIT_VN
#undef PG8_WAIT_L
#undef PG8_BAR
#undef PG8_SCHED
}
}

struct Frame {
    LAS unsigned char* lds;
    volatile LAS unsigned* MISC;
    unsigned* ctl;
    int tid, lane, wave, G, bid;
    const float* in[24]; float* out; unsigned char* ws;
};
#define WSP(T, off) ((T*)(F.ws + (off)))

__device__ __forceinline__ int dest_row(int mode, int ffn, int n0) {
    if (mode == 0) return n0;
    if (mode == 1) { const int up = n0 >= ffn ? 1 : 0, j = n0 - up * ffn; return (j >> 7) * 256 + up * 128 + (j & 127); }
    const int tile = n0 >> 8, hh = (n0 & 255) >> 6, d = n0 & 63; return tile * 256 + (d >> 5) * 128 + hh * 32 + (d & 31);
}
constexpr int CV_I_IN = (D / 64) * (NIN / 32), CV_I_OUT = (GW / 64) * (D / 32), CV_I_GU = (D / 64) * (2 * FF / 32), CV_I_DN = (FF / 64) * (D / 32), CV_I_QKV = (D / 64) * (NQKV / 32), CV_I_O = (D / 64) * (D / 32);
constexpr int CV_I_MGU = (D / 64) * (2 * FFE / 32), CV_I_MDN = (FFE / 64) * (D / 32);
constexpr int CV_DENSE = CV_I_IN + CV_I_OUT + CV_I_GU + CV_I_DN + CV_I_QKV + CV_I_O, CV_NITEMS = CV_DENSE + NE * (CV_I_MGU + CV_I_MDN);
constexpr int CV_P0_END = CV_I_IN;
constexpr int CV_HID = CV_NITEMS - CV_P0_END;
constexpr int CV_B0 = CV_P0_END, CV_B1 = CV_B0 + (int)((long)CV_HID * 330 / 1000), CV_B2 = CV_B1 + (int)((long)CV_HID * 60 / 1000), CV_B3 = CV_B2 + (int)((long)CV_HID * 400 / 1000),
              CV_B4 = CV_B3 + (int)((long)CV_HID * 80 / 1000), CV_B5 = CV_B4 + (int)((long)CV_HID * 90 / 1000), CV_B6 = CV_NITEMS;
static_assert(CV_B1 >= CV_DENSE, "all dense-layer weights are converted by the end of P2");
__device__ __forceinline__ void convert_items(Frame& F, int first, int last, int gw, int NGW) {
    const int lane = F.lane, w = F.wave;
        LAS float* scr = (LAS float*)(F.lds + w * 16384);
        struct ItemD { const float* src; unsigned char* dst; int N, K, f8; };
        auto decode = [&](int it) -> ItemD {
            int r = it; const float* W; unsigned char* WT; int K, N, mode = 0, ffn = 0, f8 = 0;
            if (r < CV_I_IN) { W = F.in[6]; K = D; N = NIN; WT = F.ws + WS_WIN; }
            else if ((r -= CV_I_IN) < CV_I_OUT) { W = F.in[12]; K = GW; N = D; WT = F.ws + WS_WOUT; }
            else if ((r -= CV_I_OUT) < CV_I_GU) { W = F.in[18]; K = D; N = 2 * FF; WT = F.ws + WS_WGU; mode = 1; ffn = FF; }
            else if ((r -= CV_I_GU) < CV_I_DN) { W = F.in[19]; K = FF; N = D; WT = F.ws + WS_WD; f8 = 1; }
            else if ((r -= CV_I_DN) < CV_I_QKV) { W = F.in[13]; K = D; N = NQKV; WT = F.ws + WS_WQKV; mode = 2; }
            else if ((r -= CV_I_QKV) < CV_I_O) { W = F.in[17]; K = D; N = D; WT = F.ws + WS_WO; }
            else if ((r -= CV_I_O) < NE * CV_I_MGU) { const int e = r / CV_I_MGU; r -= e * CV_I_MGU; W = F.in[22] + (size_t)e * D * 2 * FFE; K = D; N = 2 * FFE; WT = F.ws + WS_MWGU + (size_t)e * 2 * FFE * D; mode = 1; ffn = FFE; f8 = 1; }
            else { r -= NE * CV_I_MGU; const int e = r / CV_I_MDN; r -= e * CV_I_MDN; W = F.in[23] + (size_t)e * FFE * D; K = FFE; N = D; WT = F.ws + WS_MWD + (size_t)e * D * FFE; f8 = 1; }
            const int nblk = N / 32, kb = r / nblk, nb = r - kb * nblk, k0 = 64 * kb, n0 = 32 * nb;
            ItemD d; d.src = W + (size_t)k0 * N + n0; d.dst = WT + ((size_t)dest_row(mode, ffn, n0) * K + k0) * (f8 ? 1 : 2); d.N = N; d.K = K; d.f8 = f8; return d;
        };
        constexpr int PT = 36;
        f32x4 vc[8], vn[8];
        ItemD dc, dn; dn.src = nullptr; dn.dst = nullptr; dn.N = 0; dn.K = 0; dn.f8 = 0; dc = dn;
#define CV_LOAD(v_, d_) do { const float* p_ = (d_).src + (size_t)(lane >> 3) * (d_).N + 4 * (lane & 7); _Pragma("unroll") for (int i = 0; i < 8; ++i) v_[i] = __builtin_nontemporal_load((const f32x4*)(p_ + (size_t)(8 * i) * (d_).N)); } while (0)
        int it = first + gw;
        if (it < last) { dc = decode(it); CV_LOAD(vc, dc); }
        for (; it < last; it += NGW) {
            const bool has = it + NGW < last;
            if (has) { dn = decode(it + NGW); CV_LOAD(vn, dn); }
            const float scl = dc.f8 ? SC_W : 1.0f;
            if (dc.f8) {
#pragma unroll
                for (int i = 0; i < 8; ++i) *(LAS f32x4*)(scr + (8 * i + (lane >> 3)) * PT + 4 * (lane & 7)) = vc[i] * scl;
            } else {
#pragma unroll
                for (int i = 0; i < 8; ++i) { LAS float* q = scr + (8 * i + (lane >> 3)) * 33 + 4 * (lane & 7); q[0] = vc[i][0]; q[1] = vc[i][1]; q[2] = vc[i][2]; q[3] = vc[i][3]; }
            }
            LDS_WAIT(); asm volatile("" ::: "memory");
            if (dc.f8) {
                const int n = lane >> 1, kc = lane & 1; const LAS float* sp = scr + (32 * kc) * PT + n;
                u32x4 o0, o1;
                o0.x = pk4_fp8(sp[0 * PT], sp[1 * PT], sp[2 * PT], sp[3 * PT]); o0.y = pk4_fp8(sp[4 * PT], sp[5 * PT], sp[6 * PT], sp[7 * PT]);
                o0.z = pk4_fp8(sp[8 * PT], sp[9 * PT], sp[10 * PT], sp[11 * PT]); o0.w = pk4_fp8(sp[12 * PT], sp[13 * PT], sp[14 * PT], sp[15 * PT]);
                o1.x = pk4_fp8(sp[16 * PT], sp[17 * PT], sp[18 * PT], sp[19 * PT]); o1.y = pk4_fp8(sp[20 * PT], sp[21 * PT], sp[22 * PT], sp[23 * PT]);
                o1.z = pk4_fp8(sp[24 * PT], sp[25 * PT], sp[26 * PT], sp[27 * PT]); o1.w = pk4_fp8(sp[28 * PT], sp[29 * PT], sp[30 * PT], sp[31 * PT]);
                unsigned char* dp = dc.dst + (size_t)n * dc.K + 32 * kc;
                __builtin_nontemporal_store(o0, (u32x4*)dp); __builtin_nontemporal_store(o1, (u32x4*)(dp + 16));
            } else {
                const int c = lane & 7;
#pragma unroll
                for (int j = 0; j < 4; ++j) { const int n = (lane >> 3) + 8 * j; const LAS float* sp = scr + (8 * c) * 33 + n;
                    u32x4 o; o.x = pk2(sp[0 * 33], sp[1 * 33]); o.y = pk2(sp[2 * 33], sp[3 * 33]); o.z = pk2(sp[4 * 33], sp[5 * 33]); o.w = pk2(sp[6 * 33], sp[7 * 33]);
                    *(u32x4*)(dc.dst + ((size_t)n * dc.K + 8 * c) * 2) = o; }
            }
            LDS_WAIT(); asm volatile("" ::: "memory");
            if (has) { dc = dn;
#pragma unroll
                for (int i = 0; i < 8; ++i) vc[i] = vn[i]; }
        }
#undef CV_LOAD
}

__device__ __forceinline__ void p0_prologue(Frame& F) {
    const int tid = F.tid, lane = F.lane, w = F.wave;
    {
        LAS float* sc = (LAS float*)F.lds;
        LAS float* red = (LAS float*)(F.lds + 32768);
        const float* c = F.in[1];
        for (int i = tid; i < NB * D; i += NTHR) { const float x = c[i]; sc[i] = x / (1.0f + __expf(-x)); }
        __syncthreads();
        for (int vb = F.bid; vb < 256; vb += F.G) {
            const int colg = vb * 96, l = colg / (6 * D), j0 = colg % (6 * D);
            const float* Wl = F.in[3] + (size_t)l * D * (6 * D) + j0;
            const int rr = lane / 24, cc = lane % 24; const bool act = lane < 48;
            f32x4 a[4]; for (int b = 0; b < 4; ++b) a[b] = (f32x4){0.f, 0.f, 0.f, 0.f};
            if (act) {
                for (int i0 = 0; i0 < 128; i0 += 8) {
                    f32x4 wv[8];
#pragma unroll
                    for (int i = 0; i < 8; ++i) { const int k = 16 * (i0 + i) + 2 * w + rr; wv[i] = *(const f32x4*)(Wl + (size_t)k * (6 * D) + 4 * cc); }
#pragma unroll
                    for (int i = 0; i < 8; ++i) { const int k = 16 * (i0 + i) + 2 * w + rr;
#pragma unroll
                        for (int b = 0; b < 4; ++b) a[b] += wv[i] * sc[b * D + k]; }
                }
#pragma unroll
                for (int b = 0; b < 4; ++b)
#pragma unroll
                    for (int j = 0; j < 4; ++j) red[((2 * w + rr) * 4 + b) * 96 + 4 * cc + j] = a[b][j];
            }
            __syncthreads();
            if (tid < 384) { const int b = tid / 96, col = tid % 96; float s = 0.f;
#pragma unroll
                for (int p = 0; p < 16; ++p) s += red[(p * 4 + b) * 96 + col];
                WSP(float, WS_MOD)[(size_t)(l * NB + b) * (6 * D) + j0 + col] = s + F.in[4][(size_t)l * (6 * D) + j0 + col]; }
            __syncthreads();
        }
    }
    {
        const int* pos = (const int*)F.in[2];
        for (int idx = F.bid * NTHR + tid; idx < M * 8; idx += F.G * NTHR) { const int row = idx >> 3, i = idx & 7;
            const float invf = powf(500000.0f, -(float)(2 * i) / 16.0f); const float ang = (float)pos[row] * invf;
            double t = (double)ang * 0.15915494309189535; t -= __builtin_rint(t);
            const float tf = (float)t;
            WSP(float, WS_CS)[(size_t)row * 16 + i] = __builtin_amdgcn_cosf(tf); WSP(float, WS_CS)[(size_t)row * 16 + 8 + i] = __builtin_amdgcn_sinf(tf); }
    }
    {
        const float* wsp = F.in[10]; bf16* o = WSP(bf16, WS_WSB);
        for (int idx = F.bid * NTHR + tid; idx < 8 * 128 * 128; idx += F.G * NTHR) { const int s = idx & 127, t = (idx >> 7) & 127; o[idx] = (s <= t) ? (bf16)f2bf(wsp[idx]) : (bf16)0; }
    }
    convert_items(F, 0, CV_P0_END, F.bid * NWAVES + F.wave, F.G * NWAVES);
}

template <bool ROUTER, bool SRC16 = false>
__device__ __forceinline__ void norm_phase(Frame& F, const float* src, int l, int which) {
    const int tid = F.tid, lane = F.lane, w = F.wave;
    LAS float* TA = (LAS float*)F.lds;
    LAS float* TS = (LAS float*)(F.lds + 8192);
    LAS float* RW = (LAS float*)(F.lds + 16384);
    volatile LAS int* hist = (volatile LAS int*)(F.lds + 16384 + 65536);
    const float* ng = F.in[5] + (size_t)(l * 2 + which) * D;
    if (ROUTER) { const float* rw = F.in[20]; for (int i = tid; i < D * NE; i += NTHR) { const int c = i >> 3, e = i & 7; RW[e * D + c] = rw[i]; } }
    for (int vb = F.bid; vb < 256; vb += F.G) {
        const int b = vb / 64; const float* mod = WSP(float, WS_MOD) + (size_t)(l * NB + b) * (6 * D);
        __syncthreads();
        for (int i = tid; i < D; i += NTHR) { TA[i] = ng[i] * (1.0f + mod[(which ? 4 : 1) * D + i]); TS[i] = mod[(which ? 3 : 0) * D + i]; }
        if (ROUTER && tid < 8) hist[tid] = 0;
        __syncthreads();
        f32x4 vnx[8]; u32x2 vnh[8];
        if constexpr (SRC16) { const u32x2* xr = (const u32x2*)((const bf16*)src + (size_t)(vb * 64 + w * 8) * D) + lane;
#pragma unroll
          for (int j = 0; j < 8; ++j) vnh[j] = xr[64 * j]; }
        else { const f32x4* xr = (const f32x4*)(src + (size_t)(vb * 64 + w * 8) * D) + lane;
#pragma unroll
          for (int j = 0; j < 8; ++j) vnx[j] = xr[64 * j]; }
        for (int i = 0; i < 8; ++i) {
            const int row = vb * 64 + w * 8 + i;
            f32x4 v[8]; float ss = 0.f;
#pragma unroll
            for (int j = 0; j < 8; ++j) { if constexpr (SRC16) v[j] = (f32x4){bflo(vnh[j].x), bfhi(vnh[j].x), bflo(vnh[j].y), bfhi(vnh[j].y)}; else v[j] = vnx[j]; }
            if (i < 7) {
                if constexpr (SRC16) { const u32x2* xr = (const u32x2*)((const bf16*)src + (size_t)(row + 1) * D) + lane;
#pragma unroll
                    for (int j = 0; j < 8; ++j) vnh[j] = xr[64 * j]; }
                else { const f32x4* xr = (const f32x4*)(src + (size_t)(row + 1) * D) + lane;
#pragma unroll
                    for (int j = 0; j < 8; ++j) vnx[j] = xr[64 * j]; } }
#pragma unroll
            for (int j = 0; j < 8; ++j) ss += (v[j][0] * v[j][0] + v[j][1] * v[j][1]) + (v[j][2] * v[j][2] + v[j][3] * v[j][3]);
            const float rstd = __builtin_amdgcn_rsqf(wave_sum(ss) * (1.0f / D) + EPS);
            u32x2* o8 = (u32x2*)(WSP(bf16, WS_H) + (size_t)row * D) + lane;
#pragma unroll
            for (int j = 0; j < 8; ++j) { const f32x4 a = *(const LAS f32x4*)(TA + 256 * j + 4 * lane), s = *(const LAS f32x4*)(TS + 256 * j + 4 * lane);
                v[j] = v[j] * rstd * a + s;
                if (ROUTER) ((unsigned*)(WSP(unsigned char, WS_H) + (size_t)row * D) + lane)[64 * j] = pk4_fp8(v[j][0] * SC_H, v[j][1] * SC_H, v[j][2] * SC_H, v[j][3] * SC_H);
                else o8[64 * j] = (u32x2){pk2(v[j][0], v[j][1]), pk2(v[j][2], v[j][3])}; }
            if (ROUTER) {
                float lg[8];
#pragma unroll
                for (int e = 0; e < 8; ++e) { float a = 0.f;
#pragma unroll
                    for (int j = 0; j < 8; ++j) { const f32x4 r = *(const LAS f32x4*)(RW + e * D + 256 * j + 4 * lane); a += (v[j][0] * r[0] + v[j][1] * r[1]) + (v[j][2] * r[2] + v[j][3] * r[3]); }
                    lg[e] = wave_sum(a) + F.in[21][e]; }
                int e1 = 0; float l1 = lg[0];
#pragma unroll
                for (int e = 1; e < 8; ++e) if (lg[e] > l1) { l1 = lg[e]; e1 = e; }
                int e2 = -1; float l2 = -3.0e38f;
#pragma unroll
                for (int e = 0; e < 8; ++e) if (e != e1 && lg[e] > l2) { l2 = lg[e]; e2 = e; }
                const float ex = __expf(l2 - l1), w1 = 1.0f / (1.0f + ex), w2 = ex * w1;
                if (lane == 0) { WSP(int, WS_TOKE)[row] = e1 | (e2 << 8); WSP(f32x2, WS_TOKW)[row] = (f32x2){w1, w2}; atomicAdd((int*)&hist[e1], 1); atomicAdd((int*)&hist[e2], 1); }
            }
        }
        if (ROUTER) { __syncthreads(); if (tid < 8) ((int*)F.ctl)[CW_CNT + vb * 8 + tid] = hist[tid]; }
    }
}

__device__ __forceinline__ void gate_phase(Frame& F, bf16* Uo) {
    const int tid = F.tid, lane = F.lane, w = F.wave, i16 = lane & 15, quad = lane >> 4;
    constexpr int PITCH = 528;
    LAS unsigned char* VN = F.lds;
    LAS f32x2* ST = (LAS f32x2*)(F.lds + 128 * PITCH);
    const bf16* Vv = WSP(bf16, WS_V); const bf16* Uu = WSP(bf16, WS_U);
    const int cg = tid & 31, rb = tid >> 5;
    u32x4 vreg[8], ureg[8]; f32x4 lg0, lg1, lb0, lb1;
#define GATE_STATS(u_, buf_) do { const int row0_ = ((u_) >> 3) * 128; const int row_ = tid >> 2, part_ = tid & 3; const f32x4* p_ = (const f32x4*)(WSP(f32x2, WS_VST) + (size_t)(row0_ + row_) * 64 + part_ * 16); \
        float s_ = 0.f, q_ = 0.f; _Pragma("unroll") for (int i_ = 0; i_ < 8; ++i_) { const f32x4 x_ = p_[i_]; s_ += x_[0] + x_[2]; q_ += x_[1] + x_[3]; } \
        s_ += __shfl_xor(s_, 1); s_ += __shfl_xor(s_, 2); q_ += __shfl_xor(q_, 1); q_ += __shfl_xor(q_, 2); \
        const float mean_ = s_ * (1.0f / GW), var_ = q_ * (1.0f / GW) - mean_ * mean_; \
        if (part_ == 0) ST[(buf_) * 128 + row_] = (f32x2){mean_, __builtin_amdgcn_rsqf(fmaxf(var_, 0.f) + EPS)}; } while (0)
#define GATE_LOAD(ci_) do { const int u_ = F.bid + F.G * ((ci_) >> 1); if (u_ < 1024) { const int row0_ = (u_ >> 3) * 128, c0_ = (u_ & 7) * 512 + ((ci_) & 1) * 256; \
        lg0 = *(const f32x4*)(F.in[8] + c0_ + 8 * cg); lg1 = *(const f32x4*)(F.in[8] + c0_ + 8 * cg + 4); lb0 = *(const f32x4*)(F.in[9] + c0_ + 8 * cg); lb1 = *(const f32x4*)(F.in[9] + c0_ + 8 * cg + 4); \
        _Pragma("unroll") for (int ps_ = 0; ps_ < 8; ++ps_) vreg[ps_] = *(const u32x4*)(Vv + (size_t)(row0_ + rb + 16 * ps_) * GW + c0_ + 8 * cg); \
        _Pragma("unroll") for (int np_ = 0; np_ < 8; ++np_) ureg[np_] = *(const u32x4*)(Uu + (size_t)(row0_ + 16 * w + i16) * GW + c0_ + 8 * quad + 32 * np_); } } while (0)
    if (F.bid < 1024) { GATE_STATS(F.bid, 0); GATE_LOAD(0); }
    bf16x8 af[4]; float bs = 0.f;
    const int nks = (w >> 1) + 1;
    for (int ci = 0; ; ++ci) {
        const int u = F.bid + F.G * (ci >> 1); if (u >= 1024) break;
        const int ch = u >> 3, g = u & 7, dc = ci & 1, row0 = ch * 128, c0 = g * 512 + dc * 256, buf = (ci >> 1) & 1;
        __syncthreads();
        if (dc == 0) {
#pragma unroll
            for (int ks = 0; ks < 4; ++ks) af[ks] = *(const bf16x8*)(WSP(bf16, WS_WSB) + (size_t)(g * 128 + 16 * w + i16) * 128 + 32 * ks + 8 * quad);
            bs = F.in[11][g * 128 + 16 * w + i16];
        }
#pragma unroll
        for (int ps = 0; ps < 8; ++ps) { const int row = rb + 16 * ps; const u32x4 x = vreg[ps]; const f32x2 st = ST[buf * 128 + row];
            f32x4 lo = (f32x4){bflo(x.x), bfhi(x.x), bflo(x.y), bfhi(x.y)}, hi = (f32x4){bflo(x.z), bfhi(x.z), bflo(x.w), bfhi(x.w)};
            lo = (lo - st.x) * st.y * lg0 + lb0; hi = (hi - st.x) * st.y * lg1 + lb1;
            u32x4 o; o.x = pk2(lo[0], lo[1]); o.y = pk2(lo[2], lo[3]); o.z = pk2(hi[0], hi[1]); o.w = pk2(hi[2], hi[3]);
            *(LAS u32x4*)(VN + row * PITCH + 16 * cg) = o; }
        u32x4 uc[8];
#pragma unroll
        for (int np = 0; np < 8; ++np) uc[np] = ureg[np];
        __syncthreads();
        { const int un = F.bid + F.G * ((ci + 1) >> 1); if (dc == 1 && un < 1024) GATE_STATS(un, buf ^ 1); }
        GATE_LOAD(ci + 1);
        const size_t grow = (size_t)(row0 + 16 * w + i16) * GW + c0 + 8 * quad;
#pragma unroll
        for (int np = 0; np < 8; ++np) {
            f32x4 acc0 = (f32x4){0.f, 0.f, 0.f, 0.f}, acc1 = acc0;
            for (int ks = 0; ks < nks; ++ks) {
                const LAS unsigned char* p = VN + (32 * ks + 8 * quad + (i16 >> 2)) * PITCH + (32 * np + 8 * (i16 & 3)) * 2;
                const s16x4 lo0 = __builtin_bit_cast(s16x4, __builtin_amdgcn_ds_read_tr16_b64_v4i16((LAS s16x4*)p));
                const s16x4 hi0 = __builtin_bit_cast(s16x4, __builtin_amdgcn_ds_read_tr16_b64_v4i16((LAS s16x4*)(p + 4 * PITCH)));
                const s16x4 lo1 = __builtin_bit_cast(s16x4, __builtin_amdgcn_ds_read_tr16_b64_v4i16((LAS s16x4*)(p + 8)));
                const s16x4 hi1 = __builtin_bit_cast(s16x4, __builtin_amdgcn_ds_read_tr16_b64_v4i16((LAS s16x4*)(p + 4 * PITCH + 8)));
                const bf16x8 vf0 = __builtin_shufflevector(lo0, hi0, 0, 1, 2, 3, 4, 5, 6, 7), vf1 = __builtin_shufflevector(lo1, hi1, 0, 1, 2, 3, 4, 5, 6, 7);
                const bf16x8 a = ks == 0 ? af[0] : (ks == 1 ? af[1] : (ks == 2 ? af[2] : af[3]));
                acc0 = __builtin_amdgcn_mfma_f32_16x16x32_bf16(vf0, a, acc0, 0, 0, 0);
                acc1 = __builtin_amdgcn_mfma_f32_16x16x32_bf16(vf1, a, acc1, 0, 0, 0);
            }
            const u32x4 uv = uc[np];
            u32x4 o;
            o.x = pk2(bflo(uv.x) * (acc0[0] + bs), bfhi(uv.x) * (acc0[1] + bs)); o.y = pk2(bflo(uv.y) * (acc0[2] + bs), bfhi(uv.y) * (acc0[3] + bs));
            o.z = pk2(bflo(uv.z) * (acc1[0] + bs), bfhi(uv.z) * (acc1[1] + bs)); o.w = pk2(bflo(uv.w) * (acc1[2] + bs), bfhi(uv.w) * (acc1[3] + bs));
            *(u32x4*)(Uo + grow + 32 * np) = o;
        }
    }
#undef GATE_STATS
#undef GATE_LOAD
}

__device__ __forceinline__ void attn_phase(Frame& F, bf16* Oo) {
    const int tid = F.tid, lane = F.lane, w = F.wave, i16 = lane & 15, quad = lane >> 4;
    constexpr int PITCH = 144, KROWS = 272;
    LAS unsigned char* KS = F.lds; LAS unsigned char* VS = F.lds + KROWS * PITCH;
    const bf16* Kb = WSP(bf16, WS_KB); const bf16* Vb = WSP(bf16, WS_VB); const bf16* Q = WSP(bf16, WS_Q);
    constexpr float LOG2E = 1.44269504089f, NEG = -1.0e30f;
    u32x4 kreg[5], vreg[5];
    auto load_kv = [&](int u) {
        const int b = u >> 7, qb = (u >> 2) & 31, kvh = u & 3;
#pragma unroll
        for (int i = 0; i < 5; ++i) { const int idx = tid + NTHR * i, rr = idx >> 3, chk = idx & 7; const int kp = (qb - 1) * 128 + rr;
            kreg[i] = (u32x4){0u, 0u, 0u, 0u}; vreg[i] = kreg[i];
            if (idx < KROWS * 8 && rr < 256 && kp >= 0) { const size_t off = (size_t)(b * SEQ + kp) * (4 * HD) + kvh * HD + chk * 8; kreg[i] = *(const u32x4*)(Kb + off); vreg[i] = *(const u32x4*)(Vb + off); } }
    };
    int u = F.bid;
    if (u < 512) load_kv(u);
    for (; u < 512; u += F.G) {
        const int b = u >> 7, qb = (u >> 2) & 31, kvh = u & 3;
        __syncthreads();
#pragma unroll
        for (int i = 0; i < 5; ++i) { const int idx = tid + NTHR * i, rr = idx >> 3, chk = idx & 7;
            if (idx < KROWS * 8) { *(LAS u32x4*)(KS + rr * PITCH + chk * 16) = kreg[i]; *(LAS u32x4*)(VS + rr * PITCH + chk * 16) = vreg[i]; } }
        __syncthreads();
        if (u + F.G < 512) load_kv(u + F.G);
        const int h = kvh * 8 + w; const float sink = F.in[16][h];
        const size_t qbase = (size_t)(b * SEQ + qb * 128 + i16) * D + h * HD + 8 * quad;
        bf16x8 qn0 = *(const bf16x8*)(Q + qbase), qn1 = *(const bf16x8*)(Q + qbase + 32);
#pragma unroll 2
        for (int mt = 0; mt < 8; ++mt) {
            const bf16x8 qf0 = qn0, qf1 = qn1;
            if (mt < 7) { qn0 = *(const bf16x8*)(Q + qbase + (size_t)(16 * (mt + 1)) * D); qn1 = *(const bf16x8*)(Q + qbase + (size_t)(16 * (mt + 1)) * D + 32); }
            f32x4 st[9];
#pragma unroll
            for (int kt = 0; kt < 9; ++kt) { st[kt] = (f32x4){0.f, 0.f, 0.f, 0.f};
                const LAS unsigned char* kp = KS + (16 * (mt + kt) + i16) * PITCH + 16 * quad;
                st[kt] = __builtin_amdgcn_mfma_f32_16x16x32_bf16(*(const LAS bf16x8*)kp, qf0, st[kt], 0, 0, 0);
                st[kt] = __builtin_amdgcn_mfma_f32_16x16x32_bf16(*(const LAS bf16x8*)(kp + 64), qf1, st[kt], 0, 0, 0); }
#pragma unroll
            for (int j = 0; j < 4; ++j) { st[0][j] = (i16 < 4 * quad + j) ? st[0][j] : NEG; st[8][j] = (i16 >= 4 * quad + j) ? st[8][j] : NEG; }
            if (qb == 0) {
#pragma unroll
                for (int kt = 0; kt < 8; ++kt) if (mt + kt < 8) st[kt] = (f32x4){NEG, NEG, NEG, NEG};
            }
            float mx = sink;
#pragma unroll
            for (int kt = 0; kt < 9; ++kt) mx = fmaxf(fmaxf(mx, fmaxf(st[kt][0], st[kt][1])), fmaxf(st[kt][2], st[kt][3]));
            mx = fmaxf(mx, __shfl_xor(mx, 16)); mx = fmaxf(mx, __shfl_xor(mx, 32));
            const float mxs = mx * LOG2E; float sum = 0.f;
#pragma unroll
            for (int kt = 0; kt < 9; ++kt)
#pragma unroll
                for (int j = 0; j < 4; ++j) { const float pv_ = fast_exp2(st[kt][j] * LOG2E - mxs); st[kt][j] = pv_; sum += pv_; }
            sum += __shfl_xor(sum, 16); sum += __shfl_xor(sum, 32);
            const float inv = 1.0f / (sum + fast_exp2(sink * LOG2E - mxs));
            f32x4 o[4];
#pragma unroll
            for (int dt = 0; dt < 4; ++dt) o[dt] = (f32x4){0.f, 0.f, 0.f, 0.f};
#pragma unroll
            for (int kk = 0; kk < 5; ++kk) {
                u32x4 pw; pw.x = cvt_pk_bf16(st[2 * kk][0], st[2 * kk][1]); pw.y = cvt_pk_bf16(st[2 * kk][2], st[2 * kk][3]);
                if (kk < 4) { pw.z = cvt_pk_bf16(st[2 * kk + 1][0], st[2 * kk + 1][1]); pw.w = cvt_pk_bf16(st[2 * kk + 1][2], st[2 * kk + 1][3]); } else { pw.z = 0u; pw.w = 0u; }
                const bf16x8 pf = __builtin_bit_cast(bf16x8, pw);
#pragma unroll
                for (int dt = 0; dt < 4; ++dt) {
                    const LAS unsigned char* p = VS + (16 * (mt + 2 * kk) + 4 * quad + (i16 >> 2)) * PITCH + (16 * dt + 4 * (i16 & 3)) * 2;
                    const s16x4 lo = __builtin_bit_cast(s16x4, __builtin_amdgcn_ds_read_tr16_b64_v4i16((LAS s16x4*)p));
                    const s16x4 hi = __builtin_bit_cast(s16x4, __builtin_amdgcn_ds_read_tr16_b64_v4i16((LAS s16x4*)(p + 16 * PITCH)));
                    const bf16x8 vf = __builtin_shufflevector(lo, hi, 0, 1, 2, 3, 4, 5, 6, 7);
                    o[dt] = __builtin_amdgcn_mfma_f32_16x16x32_bf16(vf, pf, o[dt], 0, 0, 0);
                }
            }
            const size_t qrow = (size_t)(b * SEQ + qb * 128 + 16 * mt + i16);
#pragma unroll
            for (int dt = 0; dt < 4; ++dt) { const f32x4 r = o[dt] * inv; *(u32x2*)(Oo + qrow * D + h * HD + 16 * dt + 4 * quad) = (u32x2){cvt_pk_bf16(r[0], r[1]), cvt_pk_bf16(r[2], r[3])}; }
        }
    }
}

__device__ __forceinline__ void scatter_phase(Frame& F) {
    const int tid = F.tid, lane = F.lane, w = F.wave;
    volatile LAS int* CN = (volatile LAS int*)F.lds;
    volatile LAS int* NEe = CN + 2048;
    volatile LAS int* BASE = NEe + 8;
    volatile LAS int* OFFS = BASE + 8;
    volatile LAS int* SL = OFFS + 8;
    const int* cnt = (const int*)F.ctl + CW_CNT;
    __syncthreads();
    for (int i = tid; i < 2048; i += NTHR) CN[i] = cnt[i];
    __syncthreads();
    { int n = 0;
#pragma unroll
      for (int q = 0; q < 4; ++q) n += CN[(lane + 64 * q) * 8 + w];
      n = (int)wave_sum((float)n); if (lane == 0) NEe[w] = n; }
    __syncthreads();
    if (tid == 0) { int tb = 0; for (int e = 0; e < 8; ++e) { BASE[e] = tb * 256; if (F.bid == 0) { ((int*)F.ctl)[CW_META + e] = NEe[e]; ((int*)F.ctl)[CW_META + 8 + e] = tb; } tb += (NEe[e] + 255) >> 8; }
        if (F.bid == 0) { ((int*)F.ctl)[CW_META + 16] = tb; ((int*)F.ctl)[CW_META + 17] = tb; } }
    __syncthreads();
    const bf16* H = WSP(bf16, WS_H); unsigned char* AS = WSP(unsigned char, WS_AS);
    for (int vb = F.bid; vb < 256; vb += F.G) {
        __syncthreads();
        { int n = 0;
#pragma unroll
          for (int q = 0; q < 4; ++q) { const int b = lane + 64 * q; n += (b < vb) ? CN[b * 8 + w] : 0; }
          n = (int)wave_sum((float)n); if (lane == 0) OFFS[w] = n; }
        __syncthreads();
        if (w == 0) {
            const int tok = vb * 64 + lane; const int ee = WSP(int, WS_TOKE)[tok]; const int e1 = ee & 0xff, e2 = (ee >> 8) & 0xff;
            const unsigned long long lt = (1ull << lane) - 1ull;
            int s1 = 0, s2 = 0;
#pragma unroll
            for (int e = 0; e < 8; ++e) { const unsigned long long m1 = __ballot(e1 == e), m2 = __ballot(e2 == e); const int base = BASE[e] + OFFS[e];
                if (e1 == e) s1 = base + __popcll(m1 & lt); if (e2 == e) s2 = base + __popcll(m1) + __popcll(m2 & lt); }
            WSP(int, WS_SLOT)[2 * tok] = s1; WSP(int, WS_SLOT)[2 * tok + 1] = s2; SL[2 * lane] = s1; SL[2 * lane + 1] = s2;
        }
        __syncthreads();
        if (tid < 128) WSP(unsigned, WS_TOKOF)[SL[tid]] = (unsigned)(vb * 64 + (tid >> 1));
        if (vb < 8) { const int n = NEe[vb], first = BASE[vb] + n, end = BASE[vb] + (((n + 255) >> 8) << 8);
            for (int r = first + tid; r < end; r += NTHR) WSP(unsigned, WS_TOKOF)[r] = 0u; }
    }
}

__device__ __forceinline__ void combine_phase(Frame& F, float* outp) {
    const int lane = F.lane; const int gw = F.bid * NWAVES + F.wave, NGW = F.G * NWAVES;
    const bf16* OE = WSP(bf16, WS_OE);
    for (int row = gw; row < M; row += NGW) {
        const int b = row / SEQ; const float* g2 = WSP(float, WS_MOD) + (size_t)(1 * NB + b) * (6 * D) + 5 * D;
        const int s1 = WSP(int, WS_SLOT)[2 * row], s2 = WSP(int, WS_SLOT)[2 * row + 1]; const f32x2 tw = WSP(f32x2, WS_TOKW)[row];
        const u32x4* p1 = (const u32x4*)(OE + (size_t)s1 * D) + lane; const u32x4* p2 = (const u32x4*)(OE + (size_t)s2 * D) + lane;
        const bool t1 = s1 >= MAIN_TILES * 256, t2 = s2 >= MAIN_TILES * 256; const float* TPp = WSP(float, WS_TP);
        const bf16* irow = WSP(bf16, WS_XB) + (size_t)row * D; float* orow = outp + (size_t)row * D;
#pragma unroll
        for (int j = 0; j < 4; ++j) { const u32x4 a = p1[64 * j], c = p2[64 * j]; const int col = 8 * (64 * j + lane);
            const u32x4 xw = *(const u32x4*)(irow + col); const f32x4 x0 = (f32x4){bflo(xw.x), bfhi(xw.x), bflo(xw.y), bfhi(xw.y)}, x1 = (f32x4){bflo(xw.z), bfhi(xw.z), bflo(xw.w), bfhi(xw.w)}, g0 = *(const f32x4*)(g2 + col), g1 = *(const f32x4*)(g2 + col + 4);
            f32x4 a0 = (f32x4){bflo(a.x), bfhi(a.x), bflo(a.y), bfhi(a.y)}, a1 = (f32x4){bflo(a.z), bfhi(a.z), bflo(a.w), bfhi(a.w)};
            f32x4 c0 = (f32x4){bflo(c.x), bfhi(c.x), bflo(c.y), bfhi(c.y)}, c1 = (f32x4){bflo(c.z), bfhi(c.z), bflo(c.w), bfhi(c.w)};
            if (t1) { a0 = (f32x4){0.f, 0.f, 0.f, 0.f}; a1 = a0;
#pragma unroll
                for (int ks = 0; ks < TAIL_KSPLIT; ++ks) { const float* q = TPp + ((size_t)ks * TAIL_ROWS + (s1 - MAIN_TILES * 256)) * D + col; a0 += *(const f32x4*)q; a1 += *(const f32x4*)(q + 4); } }
            if (t2) { c0 = (f32x4){0.f, 0.f, 0.f, 0.f}; c1 = c0;
#pragma unroll
                for (int ks = 0; ks < TAIL_KSPLIT; ++ks) { const float* q = TPp + ((size_t)ks * TAIL_ROWS + (s2 - MAIN_TILES * 256)) * D + col; c0 += *(const f32x4*)q; c1 += *(const f32x4*)(q + 4); } }
            const f32x4 y0 = a0 * tw.x + c0 * tw.y, y1 = a1 * tw.x + c1 * tw.y;
            *(f32x4*)(orow + col) = x0 + g0 * y0; *(f32x4*)(orow + col + 4) = x1 + g1 * y1; }
    }
}

constexpr int NPHASE = 17;
struct Args { const float* in[24]; float* out; unsigned char* ws; int ph_lo, ph_hi; };
__global__ void __launch_bounds__(NTHR, 2) mk_fwd(Args args) {
    extern __shared__ __attribute__((aligned(16))) unsigned char lds[];
    Frame F;
    F.lds = (LAS unsigned char*)lds; F.MISC = (volatile LAS unsigned*)(F.lds + MISC_OFF);
    F.tid = threadIdx.x; F.lane = F.tid & 63; F.wave = __builtin_amdgcn_readfirstlane(F.tid >> 6); F.G = gridDim.x; F.bid = blockIdx.x;
    F.ws = args.ws; F.ctl = (unsigned*)(args.ws + WS_CTL); F.out = args.out;
#pragma unroll
    for (int i = 0; i < 24; ++i) F.in[i] = args.in[i];
    for (int u = F.tid; u < (LDS_BYTES - MISC_OFF) / 4; u += NTHR) ((LAS unsigned*)(F.lds + MISC_OFF))[u] = 0u;
    __syncthreads();
    XcdBarrier bar; bar.bar = F.ctl + CW_BAR; bar.x = 0; bar.st = nullptr;
    if (!MK_PER_PHASE) bar = xcd_barrier_post(F.ctl + CW_BAR, F.MISC + 8);
    const int lo = args.ph_lo, hi = args.ph_hi;
#define IN(k) (lo <= (k) && (k) < hi)
#define SEAM(k) do { if (IN(k) && IN((k) + 1)) xcd_barrier(bar); } while (0)
    const float* MOD = WSP(float, WS_MOD);
    const bool grpA = (F.bid & 7) < 4;
#define CONV_PRE(lo_, hi_) do { if (grpA) { convert_items(F, lo_, hi_, F.bid * NWAVES + F.wave, F.G * NWAVES); __syncthreads(); } } while (0)
#define CONV_POST(lo_, hi_) do { if (!grpA) convert_items(F, lo_, hi_, F.bid * NWAVES + F.wave, F.G * NWAVES); } while (0)
    volatile LAS int* TB = (volatile LAS int*)(F.lds + MISC_OFF + 256);
#define FRESH() do { int l_ = (int)__builtin_amdgcn_mbcnt_hi(~0u, __builtin_amdgcn_mbcnt_lo(~0u, 0u)); asm volatile("" : "+v"(l_)); F.lane = l_; F.tid = F.wave * 64 + l_; } while (0)

    if (IN(0)) { FRESH(); for (int r_ = 0; r_ < (PROBE_DUP == 0 ? 2 : 1); ++r_) { p0_prologue(F); __syncthreads(); } } SEAM(0);
    if (IN(1)) { FRESH(); for (int r_ = 0; r_ < (PROBE_DUP == 1 ? 2 : 1); ++r_) norm_phase<false>(F, F.in[0], 0, 0); } SEAM(1);
    if (IN(2)) { FRESH(); CONV_PRE(CV_B0, CV_B1); pg8::Gemm g{WSP(bf16, WS_H), WSP(bf16, WS_WIN), 2 * D, 0, 0, nullptr}; pg8::Order S; S.init(M / 256, NIN / 256, F.G, F.bid, nullptr);
        pg8::EpiGelu E{WSP(bf16, WS_U), WSP(bf16, WS_V), F.in[7], WSP(f32x2, WS_VST)}; pg8::gemm_phase(F.lds, g, S, E);  CONV_POST(CV_B0, CV_B1); } SEAM(2);
    if (IN(3)) { FRESH(); if (PROBE_DUP == 3) gate_phase(F, WSP(bf16, WS_FFH)); gate_phase(F, WSP(bf16, WS_U)); } SEAM(3);
    if (IN(4)) { FRESH(); CONV_PRE(CV_B1, CV_B2); pg8::Gemm g{WSP(bf16, WS_U), WSP(bf16, WS_WOUT), 2 * GW, 0, 0, nullptr}; pg8::Order S; S.init(M / 256, D / 256, F.G, F.bid, nullptr);
        pg8::EpiResB<true> E{F.in[0], WSP(bf16, WS_XB), MOD + 2 * D, 1.f}; pg8::gemm_phase(F.lds, g, S, E);  CONV_POST(CV_B1, CV_B2); } SEAM(4);
    if (IN(5)) { FRESH(); norm_phase<false, true>(F, WSP(float, WS_XB), 0, 1); } SEAM(5);
    if (IN(6)) { FRESH(); CONV_PRE(CV_B2, CV_B3); pg8::Gemm g{WSP(bf16, WS_H), WSP(bf16, WS_WGU), 2 * D, 0, 0, nullptr}; pg8::Order S; S.init(M / 256, 2 * FF / 256, F.G, F.bid, nullptr);
        pg8::EpiSwiglu8 E{WSP(unsigned char, WS_FFH), FF, 1.0f, SC_HID}; pg8::gemm_phase(F.lds, g, S, E);  CONV_POST(CV_B2, CV_B3); } SEAM(6);
    if (IN(7)) { FRESH(); CONV_PRE(CV_B3, CV_B4); pg8::Gemm g{WSP(unsigned char, WS_FFH), WSP(unsigned char, WS_WD), FF, 0, 0, nullptr}; pg8::Order S; S.init(M / 256, D / 256, F.G, F.bid, nullptr);
        pg8::EpiResB<false> E{nullptr, WSP(bf16, WS_XB), MOD + 5 * D, 1.0f / (SC_HID * SC_W)}; pg8::gemm_phase<pg8::EpiResB<false>, true>(F.lds, g, S, E);  CONV_POST(CV_B3, CV_B4); } SEAM(7);
    if (IN(8)) { FRESH(); norm_phase<false, true>(F, WSP(float, WS_XB), 1, 0); } SEAM(8);
    const bool p9all = F.G != 256, p9two = F.bid >= 128;
    if (IN(9)) { FRESH(); if (p9all) CONV_PRE(CV_B4, CV_B5); else if (p9two && grpA) { convert_items(F, CV_B4, CV_B5, (F.bid - 128) * NWAVES + F.wave, 128 * NWAVES); __syncthreads(); }
        pg8::Gemm g{WSP(bf16, WS_H), WSP(bf16, WS_WQKV), 2 * D, 0, 0, nullptr}; pg8::Order S; S.init(M / 256, NQKV / 256, F.G, F.bid, nullptr);
        pg8::EpiQKV E{WSP(bf16, WS_Q), WSP(bf16, WS_KB), WSP(bf16, WS_VB), F.in[14], F.in[15], WSP(float, WS_CS)}; pg8::gemm_phase(F.lds, g, S, E);
        if (p9all) CONV_POST(CV_B4, CV_B5); else if (p9two && !grpA) convert_items(F, CV_B4, CV_B5, (F.bid - 128) * NWAVES + F.wave, 128 * NWAVES); } SEAM(9);
    if (IN(10)) { FRESH(); if (PROBE_DUP == 10) attn_phase(F, WSP(bf16, WS_FFH)); attn_phase(F, WSP(bf16, WS_Q)); } SEAM(10);
    if (IN(11)) { FRESH(); CONV_PRE(CV_B5, CV_B6); pg8::Gemm g{WSP(bf16, WS_Q), WSP(bf16, WS_WO), 2 * D, 0, 0, nullptr}; pg8::Order S; S.init(M / 256, D / 256, F.G, F.bid, nullptr);
        pg8::EpiResB<false> E{nullptr, WSP(bf16, WS_XB), MOD + (size_t)NB * 6 * D + 2 * D, 1.f}; pg8::gemm_phase(F.lds, g, S, E);  CONV_POST(CV_B5, CV_B6); } SEAM(11);
    if (IN(12)) { FRESH(); norm_phase<true, true>(F, WSP(float, WS_XB), 1, 1); } SEAM(12);
    if (IN(13)) { FRESH(); for (int r_ = 0; r_ < (PROBE_DUP == 13 ? 2 : 1); ++r_) scatter_phase(F); } SEAM(13);
    if (IN(14) || IN(15)) { FRESH(); __syncthreads(); if (F.tid < 9) TB[F.tid] = ((const int*)F.ctl)[CW_META + 8 + F.tid]; __syncthreads(); }
    if (IN(14)) { FRESH(); const int nT = __builtin_amdgcn_readfirstlane(TB[8]); pg8::Gemm g{WSP(unsigned char, WS_H), WSP(unsigned char, WS_MWGU), D, (size_t)2 * FFE * D, 0, WSP(unsigned, WS_TOKOF)}; pg8::Order S; S.init(nT, 2 * FFE / 256, F.G, F.bid, TB);
        pg8::EpiSwiglu8 E{WSP(unsigned char, WS_HID), FFE, 1.0f / (SC_H * SC_W), SC_HID}; pg8::gemm_phase<pg8::EpiSwiglu8, true, PG8_ALIGN, true>(F.lds, g, S, E); } SEAM(14);
    if (IN(15)) { FRESH(); const int nT = __builtin_amdgcn_readfirstlane(TB[8]);
        { pg8::Gemm g{WSP(unsigned char, WS_HID), WSP(unsigned char, WS_MWD), FFE, (size_t)D * FFE, 0, nullptr}; pg8::Order S; S.init(nT < MAIN_TILES ? nT : MAIN_TILES, D / 256, F.G, F.bid, TB);
          pg8::EpiBf16 E{WSP(bf16, WS_OE), D, 1.0f / (SC_HID * SC_W)}; pg8::gemm_phase<pg8::EpiBf16, true>(F.lds, g, S, E); }
        if (nT > MAIN_TILES) { pg8::Gemm g{WSP(unsigned char, WS_HID), WSP(unsigned char, WS_MWD), FFE, (size_t)D * FFE, FFE / 128 / TAIL_KSPLIT, nullptr}; pg8::Order S; S.init_tail(MAIN_TILES, nT - MAIN_TILES, D / 256, TAIL_KSPLIT, FFE / TAIL_KSPLIT, F.G, F.bid, TB);
          pg8::EpiPart E{WSP(float, WS_TP), MAIN_TILES * 256, TAIL_ROWS, FFE / TAIL_KSPLIT, 1.0f / (SC_HID * SC_W)}; pg8::gemm_phase<pg8::EpiPart, true>(F.lds, g, S, E); } } SEAM(15);
    if (IN(16)) { FRESH(); if (PROBE_DUP == 16) combine_phase(F, WSP(float, WS_U)); combine_phase(F, F.out); }
#undef IN
#undef SEAM
#undef FRESH
}

extern "C" void kernel_launch(void* const* d_in, const int* in_sizes, int n_in, void* d_out, int out_size, void* d_ws, size_t ws_size, hipStream_t stream) {
    static int grid = 0;
    if (grid == 0) {
        if (n_in != 24 || out_size != M * D || ws_size < WS_END) { fprintf(stderr, "kernel_launch: unexpected problem (n_in %d, out %d, ws %zu); nothing launched\n", n_in, out_size, ws_size); grid = -1; return; }
        int dev = 0, cus = 0, per_cu = 0;
        if (hipGetDevice(&dev) != hipSuccess || hipDeviceGetAttribute(&cus, hipDeviceAttributeMultiprocessorCount, dev) != hipSuccess) { grid = -1; return; }
        if (hipFuncSetAttribute((const void*)mk_fwd, hipFuncAttributeMaxDynamicSharedMemorySize, LDS_BYTES) != hipSuccess) { fprintf(stderr, "kernel_launch: hipFuncSetAttribute failed\n"); grid = -1; return; }
        if (hipOccupancyMaxActiveBlocksPerMultiprocessor(&per_cu, (const void*)mk_fwd, NTHR, LDS_BYTES) != hipSuccess || per_cu < 1) fprintf(stderr, "kernel_launch: occupancy query reports %d\n", per_cu);
        (void)hipGetLastError();
        grid = cus > 256 ? 256 : cus;
    }
    if (grid < 0) return;
    (void)hipMemsetAsync((char*)d_ws + WS_CTL, 0, CTL_ZERO_BYTES, stream);
    Args a{};
    for (int i = 0; i < 24; ++i) a.in[i] = (const float*)d_in[i];
    a.out = (float*)d_out; a.ws = (unsigned char*)d_ws;
#if MK_PER_PHASE
    for (int p = 0; p < NPHASE; ++p) { a.ph_lo = p; a.ph_hi = p + 1; hipLaunchKernelGGL(mk_fwd, dim3(grid), dim3(NTHR), LDS_BYTES, stream, a); }
#else
    a.ph_lo = 0; a.ph_hi = NPHASE; hipLaunchKernelGGL(mk_fwd, dim3(grid), dim3(NTHR), LDS_BYTES, stream, a);
#endif
}
```

```cpp
#include <hip/hip_runtime.h>
#include <cstdio>
#include <cstdint>

#ifndef MK_PER_PHASE
#define MK_PER_PHASE 0
#endif

#ifndef PROBE_DUP
#define PROBE_DUP -1
#endif
#define GAS __attribute__((address_space(1)))
#define LAS __attribute__((address_space(3)))
typedef unsigned short bf16;
typedef short bf16x8 __attribute__((ext_vector_type(8)));
typedef short s16x4 __attribute__((ext_vector_type(4)));
typedef float f32x4 __attribute__((ext_vector_type(4)));
typedef float f32x2 __attribute__((ext_vector_type(2)));
typedef unsigned u32x4 __attribute__((ext_vector_type(4)));
typedef unsigned u32x2 __attribute__((ext_vector_type(2)));
typedef int i32x4 __attribute__((ext_vector_type(4)));
typedef int i32x8 __attribute__((ext_vector_type(8)));

constexpr int D = 2048, NB = 4, SEQ = 4096, M = NB * SEQ;
constexpr int GW = 4096, NIN = 2 * GW;
constexpr int FF = 5632, FFE = 7168, NE = 8;
constexpr int NQKV = 2560, HD = 64;
constexpr int SLOTS = 2 * M + NE * 256;
constexpr float EPS = 1e-6f;

constexpr size_t MiB = 1u << 20;
constexpr size_t WS_CTL = 0, CTL_ZERO_BYTES = 1 * MiB;
constexpr size_t WS_MOD = 1 * MiB;
constexpr size_t WS_CS = 2 * MiB;
constexpr size_t WS_WSB = 3 * MiB;
constexpr size_t WS_TOKE = 4 * MiB;
constexpr size_t WS_TOKW = WS_TOKE + 64 * 1024;
constexpr size_t WS_SLOT = WS_TOKW + 128 * 1024;
constexpr size_t WS_TOKOF = 5 * MiB;
constexpr size_t WS_VST = 8 * MiB;
constexpr size_t WS_WIN = 16 * MiB, WS_WOUT = 48 * MiB, WS_WGU = 64 * MiB, WS_WD = 108 * MiB, WS_WQKV = 130 * MiB, WS_WO = 140 * MiB;
constexpr size_t WS_MWGU = 148 * MiB, WS_MWD = 596 * MiB;
constexpr size_t WS_H = 820 * MiB, WS_U = 884 * MiB, WS_V = 1012 * MiB, WS_FFH = 1140 * MiB, WS_Q = 1316 * MiB, WS_KB = 1380 * MiB, WS_VB = 1388 * MiB;
constexpr size_t WS_XB = 1396 * MiB;
constexpr size_t WS_AS = 1396 * MiB, WS_HID = 1532 * MiB, WS_OE = 2008 * MiB, WS_TP = 2144 * MiB, WS_END = 2208 * MiB;
constexpr int MAIN_TILES = 2 * M / 256, TAIL_KSPLIT = 4, TAIL_ROWS = NE * 256;
static_assert(WS_AS + (size_t)SLOTS * D * 2 <= WS_HID && WS_HID + (size_t)SLOTS * FFE * 2 <= WS_OE && WS_OE + (size_t)SLOTS * D * 2 <= WS_TP && WS_TP + (size_t)TAIL_KSPLIT * TAIL_ROWS * D * 4 <= WS_END, "ws map");
static_assert(WS_FFH + (size_t)M * FF * 2 <= WS_Q && WS_MWGU + (size_t)NE * 2 * FFE * D * 2 <= WS_MWD && WS_MWD + (size_t)NE * D * FFE * 2 <= WS_H, "ws map");
constexpr int CW_BAR = 4096;
constexpr int CW_CNT = 16384;
constexpr int CW_META = 16384 + 2048;

constexpr int RING_BYTES = 131072;
constexpr int MISC_OFF = RING_BYTES;
constexpr int LDS_BYTES = 147456;
constexpr int NWAVES = 8, NTHR = 512;

#define RLX_AGENT __ATOMIC_RELAXED, __HIP_MEMORY_SCOPE_AGENT
#define LDS_WAIT() asm volatile("s_waitcnt lgkmcnt(0)" ::: "memory")
#define VM_WAIT() asm volatile("s_waitcnt vmcnt(0)" ::: "memory")
__device__ __forceinline__ unsigned f2bf(float f) { unsigned u = __builtin_bit_cast(unsigned, f); return (u + 0x7fffu + ((u >> 16) & 1u)) >> 16; }
__device__ __forceinline__ unsigned pk2(float lo, float hi) { return f2bf(lo) | (f2bf(hi) << 16); }
__device__ __forceinline__ float bf2f(unsigned short b) { return __builtin_bit_cast(float, (unsigned)b << 16); }
__device__ __forceinline__ float bflo(unsigned w) { return __builtin_bit_cast(float, w << 16); }
__device__ __forceinline__ float bfhi(unsigned w) { return __builtin_bit_cast(float, w & 0xffff0000u); }
__device__ __forceinline__ unsigned cvt_pk_bf16(float lo, float hi) { unsigned r; asm volatile("v_cvt_pk_bf16_f32 %0, %1, %2" : "=v"(r) : "v"(lo), "v"(hi)); return r; }
__device__ __forceinline__ float wave_sum(float v) {
#pragma unroll
    for (int o = 1; o < 64; o <<= 1) v += __shfl_xor(v, o);
    return v;
}
__device__ __forceinline__ float fast_exp2(float x) { return __builtin_amdgcn_exp2f(x); }
__device__ __forceinline__ float fast_rcp(float x) { return __builtin_amdgcn_rcpf(x); }
__device__ __forceinline__ unsigned pk4_fp8(float a, float b, float c, float d) {
    a = __builtin_amdgcn_fmed3f(a, -448.f, 448.f); b = __builtin_amdgcn_fmed3f(b, -448.f, 448.f); c = __builtin_amdgcn_fmed3f(c, -448.f, 448.f); d = __builtin_amdgcn_fmed3f(d, -448.f, 448.f);
    unsigned w = 0; w = __builtin_amdgcn_cvt_pk_fp8_f32(a, b, w, false); w = __builtin_amdgcn_cvt_pk_fp8_f32(c, d, w, true); return w;
}
constexpr float SC_H = 16.f, SC_W = 512.f, SC_HID = 4.f;
__device__ __forceinline__ float silu_f(float g) { return g * fast_rcp(1.0f + fast_exp2(-1.44269504089f * g)); }

#define XB_TMO      128
#define XB_XCNT(j)  (256  + 64 * (j))
#define XB_XSUB(j)  (1280 + 64 * (j))
#define XB_XGEN(j)  (2304 + 64 * (j))
#define XB_TOP      3328
#define XB_TOPGEN   3392
#define XCD_BAR_WORDS 3456
#define XB_SPIN_CAP (1u << 18)
__device__ __forceinline__ unsigned xb_ld(unsigned* p)              { return __hip_atomic_load(p, __ATOMIC_RELAXED, __HIP_MEMORY_SCOPE_AGENT); }
__device__ __forceinline__ unsigned xb_add(unsigned* p, unsigned v) { return __hip_atomic_fetch_add(p, v, __ATOMIC_RELAXED, __HIP_MEMORY_SCOPE_AGENT); }
__device__ __forceinline__ unsigned xb_xcc_id() { return (unsigned)__builtin_amdgcn_s_getreg((3 << 11) | 20) & 0xFu; }
#define XB_SPIN(cond, bar) do { unsigned _sp = 0; while (cond) { __builtin_amdgcn_s_sleep(1); \
    if ((++_sp & 255u) == 0u) { if (xb_ld(&(bar)[XB_TMO])) break; if (_sp > XB_SPIN_CAP) { atomicAdd(&(bar)[XB_TMO], 1u); break; } } } } while (0)
struct XcdBarrier { unsigned* bar; unsigned x; volatile LAS unsigned* st; };
__device__ __forceinline__ XcdBarrier xcd_barrier_post(unsigned* bar, volatile LAS unsigned* st) {
    XcdBarrier b; b.bar = bar; b.x = xb_xcc_id(); b.st = st;
    if (threadIdx.x == 0) (void)xb_add(&bar[XB_XCNT(b.x)], 1u);
    return b;
}
__device__ __forceinline__ void xcd_barrier_complete(unsigned* bar, unsigned x, unsigned& nloc, unsigned& nx) {
    const unsigned G = gridDim.x * gridDim.y * gridDim.z;
    unsigned sum, cnt, mine, sp = 0u;
    for (;;) {
        sum = 0u; cnt = 0u; mine = 0u;
#pragma unroll
        for (unsigned j = 0; j < 16; ++j) { const unsigned c = xb_ld(&bar[XB_XCNT(j)]); sum += c; cnt += (c > 0u) ? 1u : 0u; mine = (j == x) ? c : mine; }
        if (sum == G) break;
        __builtin_amdgcn_s_sleep(1);
        if ((++sp & 255u) == 0u) { if (xb_ld(&bar[XB_TMO])) break; if (sp > XB_SPIN_CAP) { atomicAdd(&bar[XB_TMO], 1u); break; } }
    }
    nloc = mine > 0u ? mine : 1u; nx = cnt > 0u ? cnt : 1u;
}
__device__ __forceinline__ void xcd_barrier(const XcdBarrier& b) {
    asm volatile("s_waitcnt vmcnt(0)" ::: "memory");
    __syncthreads();
    if (threadIdx.x == 0) {
        unsigned* bar = b.bar;
        __builtin_amdgcn_s_waitcnt(0);
        unsigned nloc = b.st[0], nx = b.st[1];
        if (nloc == 0u) { xcd_barrier_complete(bar, b.x, nloc, nx); b.st[0] = nloc; b.st[1] = nx; }
        const unsigned old = xb_add(&bar[XB_XSUB(b.x)], 1u);
        const unsigned gen = old / nloc;
        if (old + 1u == (gen + 1u) * nloc) {
            __builtin_amdgcn_fence(__ATOMIC_RELEASE, "agent");
            asm volatile("s_waitcnt vmcnt(0)" ::: "memory");
            const unsigned og = xb_add(&bar[XB_TOP], 1u);
            const unsigned tg = og / nx;
            if (og + 1u == (tg + 1u) * nx) xb_add(&bar[XB_TOPGEN], 1u);
            else XB_SPIN(xb_ld(&bar[XB_TOPGEN]) == tg, bar);
            __builtin_amdgcn_fence(__ATOMIC_ACQUIRE, "agent");
            xb_add(&bar[XB_XGEN(b.x)], 1u);
            asm volatile("s_waitcnt vmcnt(0)" ::: "memory");
        } else {
            XB_SPIN(xb_ld(&bar[XB_XGEN(b.x)]) == gen, bar);
            __builtin_amdgcn_fence(__ATOMIC_ACQUIRE, "agent");
            asm volatile("s_waitcnt vmcnt(0)" ::: "memory");
        }
    }
    __syncthreads();
}

namespace pg8 {
constexpr int BM = 256, BK = 64, HALF = 128, HTB = HALF * BK * 2, STAGE_BYTES = 8 * HTB, NXCD = 8, WGM = 8;
__host__ __device__ __forceinline__ int lds_byte(int r, int c) { const int st = (r >> 4) * 2 + (c >> 5), rr = r & 15, cc = c & 31, ob = rr * 64 + cc * 2; return st * 1024 + (ob ^ (((ob >> 9) & 1) << 5)); }
__host__ __device__ __forceinline__ void stage_rc(int b, int& R, int& C) { const int st = b / 1024, sb = b % 1024, swz = sb ^ (((sb >> 9) & 1) << 5); R = (st >> 1) * 16 + swz / 64; C = (st & 1) * 32 + (swz % 64) / 2; }
__host__ __device__ __forceinline__ int perm32(int rho) { const int n = rho >> 4, i = rho & 15; return 8 * (i >> 2) + 4 * n + (i & 3); }

struct Unit { int pm, pn, eb, koff; };
struct Gemm { const void* A; const void* Bt; int rowbytes; size_t bstride; int ktiles; const unsigned* rowoff; };

struct Order {
    int nM, nN, nwg, G, c; const volatile LAS int* tb; int ksplit, kbytes, pm0;
    __device__ void init(int nM_, int nN_, int G_, int c_, const volatile LAS int* tb_) { nM = nM_; nN = nN_; nwg = nM * nN; G = G_; c = c_; tb = tb_; ksplit = 0; kbytes = 0; pm0 = 0; }
    __device__ void init_tail(int pm0_, int nMt, int nN_, int ksplit_, int kbytes_, int G_, int c_, const volatile LAS int* tb_) { nM = nMt; nN = nN_; nwg = nMt * nN_ * ksplit_; G = G_; c = c_; tb = tb_; ksplit = ksplit_; kbytes = kbytes_; pm0 = pm0_; }
    __device__ bool next(int i, Unit& u) const {
        const long L = (long)i * G + c; if (L >= nwg) return false;
        u.eb = 0; u.koff = 0;
        if (ksplit) { u.pm = pm0 + (int)(L / (nN * ksplit)); const int rem = (int)(L % (nN * ksplit)); u.pn = rem / ksplit; u.koff = (rem % ksplit) * kbytes; }
        else {
            int wgid = (int)L; { const int q = nwg / NXCD, r = nwg % NXCD, xcd = wgid % NXCD, off = wgid / NXCD; wgid = (xcd < r ? xcd * (q + 1) : r * (q + 1) + (xcd - r) * q) + off; }
            const int nig = WGM * nN, gid = wgid / nig, fm = gid * WGM, gsz = (nM - fm) < WGM ? (nM - fm) : WGM;
            u.pm = fm + ((wgid % nig) % gsz); u.pn = (wgid % nig) / gsz; }
        if (tb) { int e = 0;
#pragma unroll
            for (int j = 1; j < 8; ++j) e += (u.pm >= __builtin_amdgcn_readfirstlane(tb[j])) ? 1 : 0;
            u.eb = e; }
        return true;
    }
};

__device__ __forceinline__ f32x2 gelu_pk(f32x2 v) {
    const f32x2 av = __builtin_elementwise_abs(v), d = av * 0.2316418882f + 1.0f;
    f32x2 t; t.x = __builtin_amdgcn_rcpf(d.x); t.y = __builtin_amdgcn_rcpf(d.y);
    f32x2 q = t * 0.5307027145f + (-0.7265760135f); q = q * t + 0.7107068705f; q = q * t + (-0.142248368f); q = q * t + 0.127414796f; q = q * t;
    const f32x2 s = (v * v) * (-0.72134752044f);
    f32x2 e; e.x = __builtin_amdgcn_exp2f(s.x); e.y = __builtin_amdgcn_exp2f(s.y);
    const f32x2 m = v * (q * e), r = v - m;
    f32x2 o; o.x = v.x < 0.f ? m.x : r.x; o.y = v.y < 0.f ? m.y : r.y; return o;
}


struct EpiGelu {
    static constexpr bool PERM = true;
    bf16* U; bf16* V; const float* bias; f32x2* vst;
    __device__ __forceinline__ void operator()(const f32x4 (&acc)[2][2][4][2], const Unit& u, int wr, int wc, int fr, int fq) const {
        const bool isv = u.pn >= 16; bf16* base = isv ? V : U; const int colt = (u.pn & 15) * BM;
        const int row0 = u.pm * BM + wr * 64 + fr, col0 = colt + wc * 32 + 8 * fq, bcol0 = u.pn * BM + wc * 32 + 8 * fq;
        f32x4 bv[2][2];
#pragma unroll
        for (int bj = 0; bj < 2; ++bj)
#pragma unroll
            for (int n = 0; n < 2; ++n) bv[bj][n] = *(const f32x4*)(bias + bcol0 + bj * HALF + 4 * n);
#pragma unroll
        for (int ai = 0; ai < 2; ++ai)
#pragma unroll
            for (int m = 0; m < 4; ++m) { const int row = row0 + ai * HALF + m * 16; bf16* rowp = base + (size_t)row * GW + col0; float s = 0.f, q = 0.f;
#pragma unroll
                for (int bj = 0; bj < 2; ++bj) { f32x4 v0 = acc[ai][bj][m][0] + bv[bj][0], v1 = acc[ai][bj][m][1] + bv[bj][1];
                    { f32x2 a = gelu_pk((f32x2){v0[0], v0[1]}), b = gelu_pk((f32x2){v0[2], v0[3]}), c = gelu_pk((f32x2){v1[0], v1[1]}), d = gelu_pk((f32x2){v1[2], v1[3]});
                      v0 = (f32x4){a.x, a.y, b.x, b.y}; v1 = (f32x4){c.x, c.y, d.x, d.y}; }
                    s += (v0[0] + v0[1]) + (v0[2] + v0[3]) + (v1[0] + v1[1]) + (v1[2] + v1[3]);
                    q += (v0[0] * v0[0] + v0[1] * v0[1]) + (v0[2] * v0[2] + v0[3] * v0[3]) + (v1[0] * v1[0] + v1[1] * v1[1]) + (v1[2] * v1[2] + v1[3] * v1[3]);
                    u32x4 w; w.x = cvt_pk_bf16(v0[0], v0[1]); w.y = cvt_pk_bf16(v0[2], v0[3]); w.z = cvt_pk_bf16(v1[0], v1[1]); w.w = cvt_pk_bf16(v1[2], v1[3]);
                    *(u32x4*)(rowp + bj * HALF) = w; }
                if (isv) { s += __shfl_xor(s, 16); s += __shfl_xor(s, 32); q += __shfl_xor(q, 16); q += __shfl_xor(q, 32);
                    if (fq == 0) vst[(size_t)row * 64 + (u.pn - 16) * 4 + wc] = (f32x2){s, q}; } }
    }
};
struct EpiRes {
    static constexpr bool PERM = false;
    const float* base; float* out; const float* gate; float sc;
    __device__ __forceinline__ void operator()(const f32x4 (&acc)[2][2][4][2], const Unit& u, int wr, int wc, int fr, int fq) const {
        const int row0 = u.pm * BM + wr * 64 + fr, col0 = u.pn * BM + wc * 32 + 4 * fq; const float* gp = gate + (size_t)((u.pm * BM) / SEQ) * (6 * D) + col0;
        f32x4 gv[2][2];
#pragma unroll
        for (int bj = 0; bj < 2; ++bj)
#pragma unroll
            for (int n = 0; n < 2; ++n) gv[bj][n] = *(const f32x4*)(gp + bj * HALF + n * 16) * sc;
#pragma unroll
        for (int ai = 0; ai < 2; ++ai)
#pragma unroll
            for (int m = 0; m < 4; ++m) { const size_t off = (size_t)(row0 + ai * HALF + m * 16) * D + col0;
#pragma unroll
                for (int bj = 0; bj < 2; ++bj)
#pragma unroll
                    for (int n = 0; n < 2; ++n) { const f32x4 b = *(const f32x4*)(base + off + bj * HALF + n * 16); *(f32x4*)(out + off + bj * HALF + n * 16) = b + gv[bj][n] * acc[ai][bj][m][n]; } }
    }
};
template <bool B32>
struct EpiResB {
    static constexpr bool PERM = true;
    const float* base32; bf16* xb; const float* gate; float sc;
    __device__ __forceinline__ void operator()(const f32x4 (&acc)[2][2][4][2], const Unit& u, int wr, int wc, int fr, int fq) const {
        const int row0 = u.pm * BM + wr * 64 + fr, col0 = u.pn * BM + wc * 32 + 8 * fq; const float* gp = gate + (size_t)((u.pm * BM) / SEQ) * (6 * D) + col0;
        f32x4 gv[2][2];
#pragma unroll
        for (int bj = 0; bj < 2; ++bj)
#pragma unroll
            for (int n = 0; n < 2; ++n) gv[bj][n] = *(const f32x4*)(gp + bj * HALF + 4 * n) * sc;
#pragma unroll
        for (int ai = 0; ai < 2; ++ai)
#pragma unroll
            for (int m = 0; m < 4; ++m) { const size_t off = (size_t)(row0 + ai * HALF + m * 16) * D + col0;
#pragma unroll
                for (int bj = 0; bj < 2; ++bj) { f32x4 b0, b1;
                    if constexpr (B32) { b0 = *(const f32x4*)(base32 + off + bj * HALF); b1 = *(const f32x4*)(base32 + off + bj * HALF + 4); }
                    else { const u32x4 x = *(const u32x4*)(xb + off + bj * HALF); b0 = (f32x4){bflo(x.x), bfhi(x.x), bflo(x.y), bfhi(x.y)}; b1 = (f32x4){bflo(x.z), bfhi(x.z), bflo(x.w), bfhi(x.w)}; }
                    const f32x4 r0 = b0 + gv[bj][0] * acc[ai][bj][m][0], r1 = b1 + gv[bj][1] * acc[ai][bj][m][1];
                    u32x4 o; o.x = cvt_pk_bf16(r0[0], r0[1]); o.y = cvt_pk_bf16(r0[2], r0[3]); o.z = cvt_pk_bf16(r1[0], r1[1]); o.w = cvt_pk_bf16(r1[2], r1[3]);
                    *(u32x4*)(xb + off + bj * HALF) = o; } }
    }
};
struct EpiSwiglu {
    static constexpr bool PERM = true;
    bf16* Hh; int ldc;
    __device__ __forceinline__ void operator()(const f32x4 (&acc)[2][2][4][2], const Unit& u, int wr, int wc, int fr, int fq) const {
        const int row0 = u.pm * BM + wr * 64 + fr, col0 = u.pn * HALF + wc * 32 + 8 * fq;
#pragma unroll
        for (int ai = 0; ai < 2; ++ai)
#pragma unroll
            for (int m = 0; m < 4; ++m) { bf16* rowp = Hh + (size_t)(row0 + ai * HALF + m * 16) * ldc + col0;
                const f32x4 g0 = acc[ai][0][m][0], g1 = acc[ai][0][m][1], u0 = acc[ai][1][m][0], u1 = acc[ai][1][m][1];
                u32x4 w; w.x = cvt_pk_bf16(silu_f(g0[0]) * u0[0], silu_f(g0[1]) * u0[1]); w.y = cvt_pk_bf16(silu_f(g0[2]) * u0[2], silu_f(g0[3]) * u0[3]);
                w.z = cvt_pk_bf16(silu_f(g1[0]) * u1[0], silu_f(g1[1]) * u1[1]); w.w = cvt_pk_bf16(silu_f(g1[2]) * u1[2], silu_f(g1[3]) * u1[3]);
                *(u32x4*)rowp = w; }
    }
};
struct EpiBf16 {
    static constexpr bool PERM = true;
    bf16* O; int ldc; float sc;
    __device__ __forceinline__ void operator()(const f32x4 (&acc)[2][2][4][2], const Unit& u, int wr, int wc, int fr, int fq) const {
        const int row0 = u.pm * BM + wr * 64 + fr, col0 = u.pn * BM + wc * 32 + 8 * fq;
#pragma unroll
        for (int ai = 0; ai < 2; ++ai)
#pragma unroll
            for (int m = 0; m < 4; ++m) { bf16* rowp = O + (size_t)(row0 + ai * HALF + m * 16) * ldc + col0;
#pragma unroll
                for (int bj = 0; bj < 2; ++bj) { const f32x4 v0 = acc[ai][bj][m][0] * sc, v1 = acc[ai][bj][m][1] * sc;
                    u32x4 w; w.x = cvt_pk_bf16(v0[0], v0[1]); w.y = cvt_pk_bf16(v0[2], v0[3]); w.z = cvt_pk_bf16(v1[0], v1[1]); w.w = cvt_pk_bf16(v1[2], v1[3]);
                    *(u32x4*)(rowp + bj * HALF) = w; } }
    }
};
struct EpiSwiglu8 {
    static constexpr bool PERM = true;
    unsigned char* Hh; int ldc; float isc, osc;
    __device__ __forceinline__ void operator()(const f32x4 (&acc)[2][2][4][2], const Unit& u, int wr, int wc, int fr, int fq) const {
        const int row0 = u.pm * BM + wr * 64 + fr, col0 = u.pn * HALF + wc * 32 + 8 * fq;
#pragma unroll
        for (int ai = 0; ai < 2; ++ai)
#pragma unroll
            for (int m = 0; m < 4; ++m) { unsigned char* rowp = Hh + (size_t)(row0 + ai * HALF + m * 16) * ldc + col0;
                const f32x4 g0 = acc[ai][0][m][0] * isc, g1 = acc[ai][0][m][1] * isc, u0 = acc[ai][1][m][0] * (isc * osc), u1 = acc[ai][1][m][1] * (isc * osc);
                u32x2 w; w.x = pk4_fp8(silu_f(g0[0]) * u0[0], silu_f(g0[1]) * u0[1], silu_f(g0[2]) * u0[2], silu_f(g0[3]) * u0[3]);
                w.y = pk4_fp8(silu_f(g1[0]) * u1[0], silu_f(g1[1]) * u1[1], silu_f(g1[2]) * u1[2], silu_f(g1[3]) * u1[3]);
                *(u32x2*)rowp = w; }
    }
};
struct EpiPart {
    static constexpr bool PERM = false;
    float* P; int row_base, nrows, kbytes; float sc;
    __device__ __forceinline__ void operator()(const f32x4 (&acc)[2][2][4][2], const Unit& u, int wr, int wc, int fr, int fq) const {
        const int row0 = u.pm * BM - row_base + wr * 64 + fr, col0 = u.pn * BM + wc * 32 + 4 * fq; float* base = P + (size_t)(u.koff / kbytes) * nrows * D;
#pragma unroll
        for (int ai = 0; ai < 2; ++ai)
#pragma unroll
            for (int m = 0; m < 4; ++m) { float* rowp = base + (size_t)(row0 + ai * HALF + m * 16) * D + col0;
#pragma unroll
                for (int bj = 0; bj < 2; ++bj)
#pragma unroll
                    for (int n = 0; n < 2; ++n) *(f32x4*)(rowp + bj * HALF + n * 16) = acc[ai][bj][m][n] * sc; }
    }
};
struct EpiQKV {
    static constexpr bool PERM = true;
    bf16* Q; bf16* Kb; bf16* Vb; const float* qg; const float* kg; const float* cs;
    __device__ __forceinline__ void operator()(const f32x4 (&acc)[2][2][4][2], const Unit& u, int wr, int wc, int fr, int fq) const {
        const int row0 = u.pm * BM + wr * 64 + fr; const int t = u.pn;
        bf16* base; int ld; const float* gn; float osc;
        if (t < 8) { base = Q + (size_t)(4 * t + wc) * HD; ld = D; gn = qg; osc = 0.125f; } else if (t == 8) { base = Kb + wc * HD; ld = 4 * HD; gn = kg; osc = 1.f; } else { base = Vb + wc * HD; ld = 4 * HD; gn = kg; osc = 1.f; }
        f32x4 gv[2][2];
#pragma unroll
        for (int bj = 0; bj < 2; ++bj)
#pragma unroll
            for (int n = 0; n < 2; ++n) gv[bj][n] = *(const f32x4*)(gn + 32 * bj + 8 * fq + 4 * n);
#pragma unroll
        for (int ai = 0; ai < 2; ++ai)
#pragma unroll
            for (int m = 0; m < 4; ++m) { const int row = row0 + ai * HALF + m * 16; bf16* rowp = base + (size_t)row * ld + 8 * fq;
                f32x4 v[2][2];
#pragma unroll
                for (int bj = 0; bj < 2; ++bj)
#pragma unroll
                    for (int n = 0; n < 2; ++n) v[bj][n] = acc[ai][bj][m][n];
                if (t < 9) {
                    float ss = 0.f;
#pragma unroll
                    for (int bj = 0; bj < 2; ++bj)
#pragma unroll
                        for (int n = 0; n < 2; ++n) ss += (v[bj][n][0] * v[bj][n][0] + v[bj][n][1] * v[bj][n][1]) + (v[bj][n][2] * v[bj][n][2] + v[bj][n][3] * v[bj][n][3]);
                    ss += __shfl_xor(ss, 16); ss += __shfl_xor(ss, 32);
                    const float r = __builtin_amdgcn_rsqf(ss * (1.0f / HD) + EPS);
#pragma unroll
                    for (int bj = 0; bj < 2; ++bj)
#pragma unroll
                        for (int n = 0; n < 2; ++n) v[bj][n] = v[bj][n] * r * gv[bj][n];
                    const float* csr = cs + (size_t)row * 16;
#pragma unroll
                    for (int n = 0; n < 2; ++n) { f32x4 cv = (f32x4){1.f, 1.f, 1.f, 1.f}, sv = (f32x4){0.f, 0.f, 0.f, 0.f};
                        if (fq < 2) { cv = *(const f32x4*)(csr + 4 * n); sv = *(const f32x4*)(csr + 8 + 4 * n); }
                        f32x4 o;
#pragma unroll
                        for (int j = 0; j < 4; ++j) o[j] = __shfl_xor(v[0][n][j], 16);
                        if (fq == 0) v[0][n] = v[0][n] * cv - o * sv; else if (fq == 1) v[0][n] = v[0][n] * cv + o * sv; }
                }
#pragma unroll
                for (int bj = 0; bj < 2; ++bj) { const f32x4 v0 = v[bj][0] * osc, v1 = v[bj][1] * osc;
                    u32x4 w; w.x = cvt_pk_bf16(v0[0], v0[1]); w.y = cvt_pk_bf16(v0[2], v0[3]); w.z = cvt_pk_bf16(v1[0], v1[1]); w.w = cvt_pk_bf16(v1[2], v1[3]);
                    *(u32x4*)(rowp + 32 * bj) = w; } }
    }
};

#ifndef PG8_ALIGN
#define PG8_ALIGN true
#endif
template <class Epi, bool F8 = false, bool ALIGN_EPI = PG8_ALIGN, bool GATH = false>
__device__ __forceinline__ void gemm_phase(LAS unsigned char* lds, const Gemm g, const Order& S, const Epi& E) {
    const int tid = threadIdx.x, wid = __builtin_amdgcn_readfirstlane(tid >> 6), lane = tid & 63, wr = wid >> 2, wc = wid & 3, fr = lane & 15, fq = lane >> 4;
    const int RB = g.rowbytes, nt = g.ktiles ? g.ktiles : RB / 128;
    unsigned voffA[2], voffB[2];
#pragma unroll
    for (int i = 0; i < 2; ++i) { int R, C; stage_rc(tid * 16 + i * 8192, R, C); const int Rb = Epi::PERM ? ((R & ~31) + perm32(R & 31)) : R;
        voffA[i] = (unsigned)(R * RB + C * 2); voffB[i] = (unsigned)(Rb * RB + C * 2); }
    unsigned gA[2], gN[2]; int gR0; unsigned gCb; { int R_, C_; stage_rc(tid * 16, R_, C_); gR0 = R_; gCb = (unsigned)(C_ * 2); }
    const size_t kstep = (size_t)(BK * 2);
    const size_t hstep = (size_t)HALF * RB;
    const size_t tstep = 2 * hstep;
    const unsigned ldsw = (unsigned)wid * 1024u;
    const int aoff = lds_byte(wr * 64 + fr, fq * 8), boff = lds_byte(wc * 32 + fr, fq * 8);
#define PG8_SA(b, h) (((b) * 2 + (h)) * HTB)
#define PG8_SB(b, h) ((4 + (b) * 2 + (h)) * HTB)
#define PG8_STAGE(bufoff, gbase, voff) do { _Pragma("unroll") for (int _i = 0; _i < 2; ++_i) \
        __builtin_amdgcn_global_load_lds((const unsigned*)((const char*)(gbase) + (voff)[_i]), (LAS unsigned*)(lds + (bufoff) + ldsw + _i * 8192), 16, 0, 0); } while (0)
#define PG8_STAGE_A(bufoff, gbase, h_, nx_) do { _Pragma("unroll") for (int _i = 0; _i < 2; ++_i) { \
        const unsigned o_ = GATH ? ((((nx_) ? gN[h_] : gA[h_]) >> (16 * _i)) & 0xffffu) * (unsigned)RB + gCb : voffA[_i]; const char* b_ = GATH ? (const char*)(gbase) : (const char*)(gbase) + ((h_) ? hstep : 0); \
        __builtin_amdgcn_global_load_lds((const unsigned*)(b_ + o_), (LAS unsigned*)(lds + (bufoff) + ldsw + _i * 8192), 16, 0, 0); } } while (0)
#define PG8_GLOAD(dst_, pm_) do { _Pragma("unroll") for (int h_ = 0; h_ < 2; ++h_) dst_[h_] = g.rowoff[(pm_) * BM + h_ * HALF + gR0] | (g.rowoff[(pm_) * BM + h_ * HALF + gR0 + 64] << 16); } while (0)
#define PG8_RD(off) (*(const LAS bf16x8*)(lds + (off)))
#define PG8_LDA(dst, b, h) do { _Pragma("unroll") for (int m = 0; m < 4; ++m) { if constexpr (F8) dst##8[m] = PG8_CAT(PG8_RD(PG8_SA(b, h) + aoff + m * 2048), PG8_RD(PG8_SA(b, h) + aoff + m * 2048 + 1024)); \
        else { dst[m][0] = PG8_RD(PG8_SA(b, h) + aoff + m * 2048); dst[m][1] = PG8_RD(PG8_SA(b, h) + aoff + m * 2048 + 1024); } } } while (0)
#define PG8_LDB(dst, b, h) do { _Pragma("unroll") for (int n = 0; n < 2; ++n) { if constexpr (F8) dst##8[n] = PG8_CAT(PG8_RD(PG8_SB(b, h) + boff + n * 2048), PG8_RD(PG8_SB(b, h) + boff + n * 2048 + 1024)); \
        else { dst[n][0] = PG8_RD(PG8_SB(b, h) + boff + n * 2048); dst[n][1] = PG8_RD(PG8_SB(b, h) + boff + n * 2048 + 1024); } } } while (0)
#define PG8_MMA(ai, bj, At, Bt) do { __builtin_amdgcn_s_setprio(1); _Pragma("unroll") for (int m = 0; m < 4; ++m) _Pragma("unroll") for (int n = 0; n < 2; ++n) { \
        if constexpr (F8) { asm volatile("v_mfma_f32_16x16x128_f8f6f4 %0, %1, %2, %0" : "+v"(acc[ai][bj][m][n]) : "v"(Bt##8[n]), "v"(At##8[m])); } \
        else { _Pragma("unroll") for (int k = 0; k < 2; ++k) acc[ai][bj][m][n] = __builtin_amdgcn_mfma_f32_16x16x32_bf16(Bt[n][k], At[m][k], acc[ai][bj][m][n], 0, 0, 0); } } \
        __builtin_amdgcn_s_setprio(0); } while (0)
#define PG8_CAT(x, y) __builtin_shufflevector(__builtin_bit_cast(i32x4, x), __builtin_bit_cast(i32x4, y), 0, 1, 2, 3, 4, 5, 6, 7)
#define PG8_WAIT_V(n) asm volatile("s_waitcnt vmcnt(" #n ")" ::: "memory")
#define PG8_WAIT_L(n) asm volatile("s_waitcnt lgkmcnt(" #n ")" ::: "memory")
#define PG8_BAR __builtin_amdgcn_s_barrier()
#define PG8_SCHED __builtin_amdgcn_sched_barrier(0)
    Unit cur, nxt; int ui = 0;
    if (!S.next(0, cur)) return;
    f32x4 acc[2][2][4][2];
#pragma unroll
    for (int a = 0; a < 2; ++a)
#pragma unroll
        for (int b = 0; b < 2; ++b)
#pragma unroll
            for (int m = 0; m < 4; ++m)
#pragma unroll
                for (int n = 0; n < 2; ++n) acc[a][b][m][n] = (f32x4){0.f, 0.f, 0.f, 0.f};
    bf16x8 At[4][2], B0[2][2], B1[2][2]; i32x8 At8[4], B08[2], B18[2];
    const char* cA = (const char*)g.A + (GATH ? (size_t)0 : (size_t)cur.pm * tstep) + cur.koff;
    if constexpr (GATH) PG8_GLOAD(gA, cur.pm); const char* cB = (const char*)g.Bt + (size_t)cur.eb * g.bstride + (size_t)cur.pn * tstep + cur.koff;
    PG8_STAGE(PG8_SB(0, 0), cB, voffB); PG8_STAGE(PG8_SB(0, 1), cB + hstep, voffB); PG8_STAGE_A(PG8_SA(0, 0), cA, 0, false); PG8_STAGE_A(PG8_SA(0, 1), cA, 1, false);
    if (wr == 1) PG8_BAR;
    PG8_WAIT_V(2); PG8_BAR;
    PG8_STAGE(PG8_SB(1, 0), cB + kstep, voffB); PG8_STAGE_A(PG8_SA(1, 0), cA + kstep, 0, false); PG8_STAGE(PG8_SB(1, 1), cB + hstep + kstep, voffB);
    PG8_WAIT_V(6); PG8_BAR;
    for (;;) {
        const bool has_next = S.next(ui + 1, nxt);
        const char* nA = has_next ? (const char*)g.A + (GATH ? (size_t)0 : (size_t)nxt.pm * tstep) + nxt.koff : cA;
        if constexpr (GATH) { if (has_next) PG8_GLOAD(gN, nxt.pm); } const char* nB = has_next ? (const char*)g.Bt + (size_t)nxt.eb * g.bstride + (size_t)nxt.pn * tstep + nxt.koff : cB;
        for (int t = 0; t < nt; t += 2) {
            const bool last = (t == nt - 2); const bool nx = last && has_next;
            const char* a1 = cA + (size_t)(t + 1) * kstep;
            const char* a2 = last ? nA : cA + (size_t)(t + 2) * kstep; const char* b2 = last ? nB : cB + (size_t)(t + 2) * kstep;
            const char* a3 = a2 + kstep; const char* b3 = b2 + kstep;
            PG8_LDB(B0, 0, 0); PG8_LDB(B1, 0, 1); PG8_SCHED; PG8_LDA(At, 0, 0); PG8_STAGE_A(PG8_SA(1, 1), a1, 1, false);
            PG8_WAIT_V(8); PG8_WAIT_L(0); PG8_BAR; PG8_MMA(0, 0, At, B0); PG8_MMA(0, 1, At, B1); PG8_BAR; PG8_SCHED;
            PG8_LDA(At, 0, 1); PG8_STAGE(PG8_SB(0, 0), b2, voffB); PG8_STAGE(PG8_SB(0, 1), b2 + hstep, voffB); PG8_STAGE_A(PG8_SA(0, 0), a2, 0, nx);
            PG8_WAIT_V(8); PG8_WAIT_L(0); PG8_BAR; PG8_MMA(1, 0, At, B0); PG8_MMA(1, 1, At, B1); PG8_BAR; PG8_SCHED;
            PG8_LDB(B0, 1, 0); PG8_LDB(B1, 1, 1); PG8_SCHED; PG8_LDA(At, 1, 0); PG8_STAGE_A(PG8_SA(0, 1), a2, 1, nx);
            PG8_WAIT_V(8); PG8_WAIT_L(0); PG8_BAR; PG8_MMA(0, 0, At, B0); PG8_MMA(0, 1, At, B1); PG8_BAR; PG8_SCHED;
            PG8_LDA(At, 1, 1); PG8_STAGE(PG8_SB(1, 0), b3, voffB); PG8_STAGE(PG8_SB(1, 1), b3 + hstep, voffB); PG8_STAGE_A(PG8_SA(1, 0), a3, 0, nx);
            PG8_WAIT_V(8); PG8_WAIT_L(0); PG8_BAR; PG8_MMA(1, 0, At, B0); PG8_MMA(1, 1, At, B1); PG8_BAR; PG8_SCHED;
        }
        if constexpr (F8) asm volatile("s_nop 15\n\ts_nop 15" ::: "memory");
        if constexpr (ALIGN_EPI) { if (wr == 0) PG8_BAR; }
        E(acc, cur, wr, wc, fr, fq);
        if (!has_next) break;
#pragma unroll
        for (int a = 0; a < 2; ++a)
#pragma unroll
            for (int b = 0; b < 2; ++b)
#pragma unroll
                for (int m = 0; m < 4; ++m)
#pragma unroll
                    for (int n = 0; n < 2; ++n) acc[a][b][m][n] = (f32x4){0.f, 0.f, 0.f, 0.f};
        cur = nxt; cA = nA; cB = nB; ++ui;
        if constexpr (GATH) { gA[0] = gN[0]; gA[1] = gN[1]; }
        if constexpr (ALIGN_EPI) { if (wr == 1) PG8_BAR; }
    }
    PG8_WAIT_V(0);
    if constexpr (!ALIGN_EPI) { if (wr == 0) PG8_BAR; }
    PG8_BAR;
#undef PG8_SA
#undef PG8_SB
#undef PG8_STAGE
#undef PG8_STAGE_A
#undef PG8_GLOAD
#undef PG8_LDA
#undef PG8_RD
#undef PG8_LDB
#undef PG8_MMA
#undef PG8_CAT
#undef PG8_WAIT_V
#undef PG8_WAIT_L
#undef PG8_BAR
#undef PG8_SCHED
}
}

struct Frame {
    LAS unsigned char* lds;
    volatile LAS unsigned* MISC;
    unsigned* ctl;
    int tid, lane, wave, G, bid;
    const float* in[24]; float* out; unsigned char* ws;
};
#define WSP(T, off) ((T*)(F.ws + (off)))

__device__ __forceinline__ int dest_row(int mode, int ffn, int n0) {
    if (mode == 0) return n0;
    if (mode == 1) { const int up = n0 >= ffn ? 1 : 0, j = n0 - up * ffn; return (j >> 7) * 256 + up * 128 + (j & 127); }
    const int tile = n0 >> 8, hh = (n0 & 255) >> 6, d = n0 & 63; return tile * 256 + (d >> 5) * 128 + hh * 32 + (d & 31);
}
constexpr int CV_I_IN = (D / 64) * (NIN / 32), CV_I_OUT = (GW / 64) * (D / 32), CV_I_GU = (D / 64) * (2 * FF / 32), CV_I_DN = (FF / 64) * (D / 32), CV_I_QKV = (D / 64) * (NQKV / 32), CV_I_O = (D / 64) * (D / 32);
constexpr int CV_I_MGU = (D / 64) * (2 * FFE / 32), CV_I_MDN = (FFE / 64) * (D / 32);
constexpr int CV_DENSE = CV_I_IN + CV_I_OUT + CV_I_GU + CV_I_DN + CV_I_QKV + CV_I_O, CV_NITEMS = CV_DENSE + NE * (CV_I_MGU + CV_I_MDN);
constexpr int CV_P0_END = CV_I_IN;
constexpr int CV_HID = CV_NITEMS - CV_P0_END;
constexpr int CV_B0 = CV_P0_END, CV_B1 = CV_B0 + (int)((long)CV_HID * 330 / 1000), CV_B2 = CV_B1 + (int)((long)CV_HID * 60 / 1000), CV_B3 = CV_B2 + (int)((long)CV_HID * 400 / 1000),
              CV_B4 = CV_B3 + (int)((long)CV_HID * 80 / 1000), CV_B5 = CV_B4 + (int)((long)CV_HID * 90 / 1000), CV_B6 = CV_NITEMS;
static_assert(CV_B1 >= CV_DENSE, "all dense-layer weights are converted by the end of P2");
__device__ __forceinline__ void convert_items(Frame& F, int first, int last, int gw, int NGW) {
    const int lane = F.lane, w = F.wave;
        LAS float* scr = (LAS float*)(F.lds + w * 16384);
        struct ItemD { const float* src; unsigned char* dst; int N, K, f8; };
        auto decode = [&](int it) -> ItemD {
            int r = it; const float* W; unsigned char* WT; int K, N, mode = 0, ffn = 0, f8 = 0;
            if (r < CV_I_IN) { W = F.in[6]; K = D; N = NIN; WT = F.ws + WS_WIN; }
            else if ((r -= CV_I_IN) < CV_I_OUT) { W = F.in[12]; K = GW; N = D; WT = F.ws + WS_WOUT; }
            else if ((r -= CV_I_OUT) < CV_I_GU) { W = F.in[18]; K = D; N = 2 * FF; WT = F.ws + WS_WGU; mode = 1; ffn = FF; }
            else if ((r -= CV_I_GU) < CV_I_DN) { W = F.in[19]; K = FF; N = D; WT = F.ws + WS_WD; f8 = 1; }
            else if ((r -= CV_I_DN) < CV_I_QKV) { W = F.in[13]; K = D; N = NQKV; WT = F.ws + WS_WQKV; mode = 2; }
            else if ((r -= CV_I_QKV) < CV_I_O) { W = F.in[17]; K = D; N = D; WT = F.ws + WS_WO; }
            else if ((r -= CV_I_O) < NE * CV_I_MGU) { const int e = r / CV_I_MGU; r -= e * CV_I_MGU; W = F.in[22] + (size_t)e * D * 2 * FFE; K = D; N = 2 * FFE; WT = F.ws + WS_MWGU + (size_t)e * 2 * FFE * D; mode = 1; ffn = FFE; f8 = 1; }
            else { r -= NE * CV_I_MGU; const int e = r / CV_I_MDN; r -= e * CV_I_MDN; W = F.in[23] + (size_t)e * FFE * D; K = FFE; N = D; WT = F.ws + WS_MWD + (size_t)e * D * FFE; f8 = 1; }
            const int nblk = N / 32, kb = r / nblk, nb = r - kb * nblk, k0 = 64 * kb, n0 = 32 * nb;
            ItemD d; d.src = W + (size_t)k0 * N + n0; d.dst = WT + ((size_t)dest_row(mode, ffn, n0) * K + k0) * (f8 ? 1 : 2); d.N = N; d.K = K; d.f8 = f8; return d;
        };
        constexpr int PT = 36;
        f32x4 vc[8], vn[8];
        ItemD dc, dn; dn.src = nullptr; dn.dst = nullptr; dn.N = 0; dn.K = 0; dn.f8 = 0; dc = dn;
#define CV_LOAD(v_, d_) do { const float* p_ = (d_).src + (size_t)(lane >> 3) * (d_).N + 4 * (lane & 7); _Pragma("unroll") for (int i = 0; i < 8; ++i) v_[i] = __builtin_nontemporal_load((const f32x4*)(p_ + (size_t)(8 * i) * (d_).N)); } while (0)
        int it = first + gw;
        if (it < last) { dc = decode(it); CV_LOAD(vc, dc); }
        for (; it < last; it += NGW) {
            const bool has = it + NGW < last;
            if (has) { dn = decode(it + NGW); CV_LOAD(vn, dn); }
            const float scl = dc.f8 ? SC_W : 1.0f;
            if (dc.f8) {
#pragma unroll
                for (int i = 0; i < 8; ++i) *(LAS f32x4*)(scr + (8 * i + (lane >> 3)) * PT + 4 * (lane & 7)) = vc[i] * scl;
            } else {
#pragma unroll
                for (int i = 0; i < 8; ++i) { LAS float* q = scr + (8 * i + (lane >> 3)) * 33 + 4 * (lane & 7); q[0] = vc[i][0]; q[1] = vc[i][1]; q[2] = vc[i][2]; q[3] = vc[i][3]; }
            }
            LDS_WAIT(); asm volatile("" ::: "memory");
            if (dc.f8) {
                const int n = lane >> 1, kc = lane & 1; const LAS float* sp = scr + (32 * kc) * PT + n;
                u32x4 o0, o1;
                o0.x = pk4_fp8(sp[0 * PT], sp[1 * PT], sp[2 * PT], sp[3 * PT]); o0.y = pk4_fp8(sp[4 * PT], sp[5 * PT], sp[6 * PT], sp[7 * PT]);
                o0.z = pk4_fp8(sp[8 * PT], sp[9 * PT], sp[10 * PT], sp[11 * PT]); o0.w = pk4_fp8(sp[12 * PT], sp[13 * PT], sp[14 * PT], sp[15 * PT]);
                o1.x = pk4_fp8(sp[16 * PT], sp[17 * PT], sp[18 * PT], sp[19 * PT]); o1.y = pk4_fp8(sp[20 * PT], sp[21 * PT], sp[22 * PT], sp[23 * PT]);
                o1.z = pk4_fp8(sp[24 * PT], sp[25 * PT], sp[26 * PT], sp[27 * PT]); o1.w = pk4_fp8(sp[28 * PT], sp[29 * PT], sp[30 * PT], sp[31 * PT]);
                unsigned char* dp = dc.dst + (size_t)n * dc.K + 32 * kc;
                __builtin_nontemporal_store(o0, (u32x4*)dp); __builtin_nontemporal_store(o1, (u32x4*)(dp + 16));
            } else {
                const int c = lane & 7;
#pragma unroll
                for (int j = 0; j < 4; ++j) { const int n = (lane >> 3) + 8 * j; const LAS float* sp = scr + (8 * c) * 33 + n;
                    u32x4 o; o.x = pk2(sp[0 * 33], sp[1 * 33]); o.y = pk2(sp[2 * 33], sp[3 * 33]); o.z = pk2(sp[4 * 33], sp[5 * 33]); o.w = pk2(sp[6 * 33], sp[7 * 33]);
                    *(u32x4*)(dc.dst + ((size_t)n * dc.K + 8 * c) * 2) = o; }
            }
            LDS_WAIT(); asm volatile("" ::: "memory");
            if (has) { dc = dn;
#pragma unroll
                for (int i = 0; i < 8; ++i) vc[i] = vn[i]; }
        }
#undef CV_LOAD
}

__device__ __forceinline__ void p0_prologue(Frame& F) {
    const int tid = F.tid, lane = F.lane, w = F.wave;
    {
        LAS float* sc = (LAS float*)F.lds;
        LAS float* red = (LAS float*)(F.lds + 32768);
        const float* c = F.in[1];
        for (int i = tid; i < NB * D; i += NTHR) { const float x = c[i]; sc[i] = x / (1.0f + __expf(-x)); }
        __syncthreads();
        for (int vb = F.bid; vb < 256; vb += F.G) {
            const int colg = vb * 96, l = colg / (6 * D), j0 = colg % (6 * D);
            const float* Wl = F.in[3] + (size_t)l * D * (6 * D) + j0;
            const int rr = lane / 24, cc = lane % 24; const bool act = lane < 48;
            f32x4 a[4]; for (int b = 0; b < 4; ++b) a[b] = (f32x4){0.f, 0.f, 0.f, 0.f};
            if (act) {
                for (int i0 = 0; i0 < 128; i0 += 8) {
                    f32x4 wv[8];
#pragma unroll
                    for (int i = 0; i < 8; ++i) { const int k = 16 * (i0 + i) + 2 * w + rr; wv[i] = *(const f32x4*)(Wl + (size_t)k * (6 * D) + 4 * cc); }
#pragma unroll
                    for (int i = 0; i < 8; ++i) { const int k = 16 * (i0 + i) + 2 * w + rr;
#pragma unroll
                        for (int b = 0; b < 4; ++b) a[b] += wv[i] * sc[b * D + k]; }
                }
#pragma unroll
                for (int b = 0; b < 4; ++b)
#pragma unroll
                    for (int j = 0; j < 4; ++j) red[((2 * w + rr) * 4 + b) * 96 + 4 * cc + j] = a[b][j];
            }
            __syncthreads();
            if (tid < 384) { const int b = tid / 96, col = tid % 96; float s = 0.f;
#pragma unroll
                for (int p = 0; p < 16; ++p) s += red[(p * 4 + b) * 96 + col];
                WSP(float, WS_MOD)[(size_t)(l * NB + b) * (6 * D) + j0 + col] = s + F.in[4][(size_t)l * (6 * D) + j0 + col]; }
            __syncthreads();
        }
    }
    {
        const int* pos = (const int*)F.in[2];
        for (int idx = F.bid * NTHR + tid; idx < M * 8; idx += F.G * NTHR) { const int row = idx >> 3, i = idx & 7;
            const float invf = powf(500000.0f, -(float)(2 * i) / 16.0f); const float ang = (float)pos[row] * invf;
            double t = (double)ang * 0.15915494309189535; t -= __builtin_rint(t);
            const float tf = (float)t;
            WSP(float, WS_CS)[(size_t)row * 16 + i] = __builtin_amdgcn_cosf(tf); WSP(float, WS_CS)[(size_t)row * 16 + 8 + i] = __builtin_amdgcn_sinf(tf); }
    }
    {
        const float* wsp = F.in[10]; bf16* o = WSP(bf16, WS_WSB);
        for (int idx = F.bid * NTHR + tid; idx < 8 * 128 * 128; idx += F.G * NTHR) { const int s = idx & 127, t = (idx >> 7) & 127; o[idx] = (s <= t) ? (bf16)f2bf(wsp[idx]) : (bf16)0; }
    }
    convert_items(F, 0, CV_P0_END, F.bid * NWAVES + F.wave, F.G * NWAVES);
}

template <bool ROUTER, bool SRC16 = false>
__device__ __forceinline__ void norm_phase(Frame& F, const float* src, int l, int which) {
    const int tid = F.tid, lane = F.lane, w = F.wave;
    LAS float* TA = (LAS float*)F.lds;
    LAS float* TS = (LAS float*)(F.lds + 8192);
    LAS float* RW = (LAS float*)(F.lds + 16384);
    volatile LAS int* hist = (volatile LAS int*)(F.lds + 16384 + 65536);
    const float* ng = F.in[5] + (size_t)(l * 2 + which) * D;
    if (ROUTER) { const float* rw = F.in[20]; for (int i = tid; i < D * NE; i += NTHR) { const int c = i >> 3, e = i & 7; RW[e * D + c] = rw[i]; } }
    for (int vb = F.bid; vb < 256; vb += F.G) {
        const int b = vb / 64; const float* mod = WSP(float, WS_MOD) + (size_t)(l * NB + b) * (6 * D);
        __syncthreads();
        for (int i = tid; i < D; i += NTHR) { TA[i] = ng[i] * (1.0f + mod[(which ? 4 : 1) * D + i]); TS[i] = mod[(which ? 3 : 0) * D + i]; }
        if (ROUTER && tid < 8) hist[tid] = 0;
        __syncthreads();
        f32x4 vnx[8]; u32x2 vnh[8];
        if constexpr (SRC16) { const u32x2* xr = (const u32x2*)((const bf16*)src + (size_t)(vb * 64 + w * 8) * D) + lane;
#pragma unroll
          for (int j = 0; j < 8; ++j) vnh[j] = xr[64 * j]; }
        else { const f32x4* xr = (const f32x4*)(src + (size_t)(vb * 64 + w * 8) * D) + lane;
#pragma unroll
          for (int j = 0; j < 8; ++j) vnx[j] = xr[64 * j]; }
        for (int i = 0; i < 8; ++i) {
            const int row = vb * 64 + w * 8 + i;
            f32x4 v[8]; float ss = 0.f;
#pragma unroll
            for (int j = 0; j < 8; ++j) { if constexpr (SRC16) v[j] = (f32x4){bflo(vnh[j].x), bfhi(vnh[j].x), bflo(vnh[j].y), bfhi(vnh[j].y)}; else v[j] = vnx[j]; }
            if (i < 7) {
                if constexpr (SRC16) { const u32x2* xr = (const u32x2*)((const bf16*)src + (size_t)(row + 1) * D) + lane;
#pragma unroll
                    for (int j = 0; j < 8; ++j) vnh[j] = xr[64 * j]; }
                else { const f32x4* xr = (const f32x4*)(src + (size_t)(row + 1) * D) + lane;
#pragma unroll
                    for (int j = 0; j < 8; ++j) vnx[j] = xr[64 * j]; } }
#pragma unroll
            for (int j = 0; j < 8; ++j) ss += (v[j][0] * v[j][0] + v[j][1] * v[j][1]) + (v[j][2] * v[j][2] + v[j][3] * v[j][3]);
            const float rstd = __builtin_amdgcn_rsqf(wave_sum(ss) * (1.0f / D) + EPS);
            u32x2* o8 = (u32x2*)(WSP(bf16, WS_H) + (size_t)row * D) + lane;
#pragma unroll
            for (int j = 0; j < 8; ++j) { const f32x4 a = *(const LAS f32x4*)(TA + 256 * j + 4 * lane), s = *(const LAS f32x4*)(TS + 256 * j + 4 * lane);
                v[j] = v[j] * rstd * a + s;
                if (ROUTER) ((unsigned*)(WSP(unsigned char, WS_H) + (size_t)row * D) + lane)[64 * j] = pk4_fp8(v[j][0] * SC_H, v[j][1] * SC_H, v[j][2] * SC_H, v[j][3] * SC_H);
                else o8[64 * j] = (u32x2){pk2(v[j][0], v[j][1]), pk2(v[j][2], v[j][3])}; }
            if (ROUTER) {
                float lg[8];
#pragma unroll
                for (int e = 0; e < 8; ++e) { float a = 0.f;
#pragma unroll
                    for (int j = 0; j < 8; ++j) { const f32x4 r = *(const LAS f32x4*)(RW + e * D + 256 * j + 4 * lane); a += (v[j][0] * r[0] + v[j][1] * r[1]) + (v[j][2] * r[2] + v[j][3] * r[3]); }
                    lg[e] = wave_sum(a) + F.in[21][e]; }
                int e1 = 0; float l1 = lg[0];
#pragma unroll
                for (int e = 1; e < 8; ++e) if (lg[e] > l1) { l1 = lg[e]; e1 = e; }
                int e2 = -1; float l2 = -3.0e38f;
#pragma unroll
                for (int e = 0; e < 8; ++e) if (e != e1 && lg[e] > l2) { l2 = lg[e]; e2 = e; }
                const float ex = __expf(l2 - l1), w1 = 1.0f / (1.0f + ex), w2 = ex * w1;
                if (lane == 0) { WSP(int, WS_TOKE)[row] = e1 | (e2 << 8); WSP(f32x2, WS_TOKW)[row] = (f32x2){w1, w2}; atomicAdd((int*)&hist[e1], 1); atomicAdd((int*)&hist[e2], 1); }
            }
        }
        if (ROUTER) { __syncthreads(); if (tid < 8) ((int*)F.ctl)[CW_CNT + vb * 8 + tid] = hist[tid]; }
    }
}

__device__ __forceinline__ void gate_phase(Frame& F, bf16* Uo) {
    const int tid = F.tid, lane = F.lane, w = F.wave, i16 = lane & 15, quad = lane >> 4;
    constexpr int PITCH = 528;
    LAS unsigned char* VN = F.lds;
    LAS f32x2* ST = (LAS f32x2*)(F.lds + 128 * PITCH);
    const bf16* Vv = WSP(bf16, WS_V); const bf16* Uu = WSP(bf16, WS_U);
    const int cg = tid & 31, rb = tid >> 5;
    u32x4 vreg[8], ureg[8]; f32x4 lg0, lg1, lb0, lb1;
#define GATE_STATS(u_, buf_) do { const int row0_ = ((u_) >> 3) * 128; const int row_ = tid >> 2, part_ = tid & 3; const f32x4* p_ = (const f32x4*)(WSP(f32x2, WS_VST) + (size_t)(row0_ + row_) * 64 + part_ * 16); \
        float s_ = 0.f, q_ = 0.f; _Pragma("unroll") for (int i_ = 0; i_ < 8; ++i_) { const f32x4 x_ = p_[i_]; s_ += x_[0] + x_[2]; q_ += x_[1] + x_[3]; } \
        s_ += __shfl_xor(s_, 1); s_ += __shfl_xor(s_, 2); q_ += __shfl_xor(q_, 1); q_ += __shfl_xor(q_, 2); \
        const float mean_ = s_ * (1.0f / GW), var_ = q_ * (1.0f / GW) - mean_ * mean_; \
        if (part_ == 0) ST[(buf_) * 128 + row_] = (f32x2){mean_, __builtin_amdgcn_rsqf(fmaxf(var_, 0.f) + EPS)}; } while (0)
#define GATE_LOAD(ci_) do { const int u_ = F.bid + F.G * ((ci_) >> 1); if (u_ < 1024) { const int row0_ = (u_ >> 3) * 128, c0_ = (u_ & 7) * 512 + ((ci_) & 1) * 256; \
        lg0 = *(const f32x4*)(F.in[8] + c0_ + 8 * cg); lg1 = *(const f32x4*)(F.in[8] + c0_ + 8 * cg + 4); lb0 = *(const f32x4*)(F.in[9] + c0_ + 8 * cg); lb1 = *(const f32x4*)(F.in[9] + c0_ + 8 * cg + 4); \
        _Pragma("unroll") for (int ps_ = 0; ps_ < 8; ++ps_) vreg[ps_] = *(const u32x4*)(Vv + (size_t)(row0_ + rb + 16 * ps_) * GW + c0_ + 8 * cg); \
        _Pragma("unroll") for (int np_ = 0; np_ < 8; ++np_) ureg[np_] = *(const u32x4*)(Uu + (size_t)(row0_ + 16 * w + i16) * GW + c0_ + 8 * quad + 32 * np_); } } while (0)
    if (F.bid < 1024) { GATE_STATS(F.bid, 0); GATE_LOAD(0); }
    bf16x8 af[4]; float bs = 0.f;
    const int nks = (w >> 1) + 1;
    for (int ci = 0; ; ++ci) {
        const int u = F.bid + F.G * (ci >> 1); if (u >= 1024) break;
        const int ch = u >> 3, g = u & 7, dc = ci & 1, row0 = ch * 128, c0 = g * 512 + dc * 256, buf = (ci >> 1) & 1;
        __syncthreads();
        if (dc == 0) {
#pragma unroll
            for (int ks = 0; ks < 4; ++ks) af[ks] = *(const bf16x8*)(WSP(bf16, WS_WSB) + (size_t)(g * 128 + 16 * w + i16) * 128 + 32 * ks + 8 * quad);
            bs = F.in[11][g * 128 + 16 * w + i16];
        }
#pragma unroll
        for (int ps = 0; ps < 8; ++ps) { const int row = rb + 16 * ps; const u32x4 x = vreg[ps]; const f32x2 st = ST[buf * 128 + row];
            f32x4 lo = (f32x4){bflo(x.x), bfhi(x.x), bflo(x.y), bfhi(x.y)}, hi = (f32x4){bflo(x.z), bfhi(x.z), bflo(x.w), bfhi(x.w)};
            lo = (lo - st.x) * st.y * lg0 + lb0; hi = (hi - st.x) * st.y * lg1 + lb1;
            u32x4 o; o.x = pk2(lo[0], lo[1]); o.y = pk2(lo[2], lo[3]); o.z = pk2(hi[0], hi[1]); o.w = pk2(hi[2], hi[3]);
            *(LAS u32x4*)(VN + row * PITCH + 16 * cg) = o; }
        u32x4 uc[8];
#pragma unroll
        for (int np = 0; np < 8; ++np) uc[np] = ureg[np];
        __syncthreads();
        { const int un = F.bid + F.G * ((ci + 1) >> 1); if (dc == 1 && un < 1024) GATE_STATS(un, buf ^ 1); }
        GATE_LOAD(ci + 1);
        const size_t grow = (size_t)(row0 + 16 * w + i16) * GW + c0 + 8 * quad;
#pragma unroll
        for (int np = 0; np < 8; ++np) {
            f32x4 acc0 = (f32x4){0.f, 0.f, 0.f, 0.f}, acc1 = acc0;
            for (int ks = 0; ks < nks; ++ks) {
                const LAS unsigned char* p = VN + (32 * ks + 8 * quad + (i16 >> 2)) * PITCH + (32 * np + 8 * (i16 & 3)) * 2;
                const s16x4 lo0 = __builtin_bit_cast(s16x4, __builtin_amdgcn_ds_read_tr16_b64_v4i16((LAS s16x4*)p));
                const s16x4 hi0 = __builtin_bit_cast(s16x4, __builtin_amdgcn_ds_read_tr16_b64_v4i16((LAS s16x4*)(p + 4 * PITCH)));
                const s16x4 lo1 = __builtin_bit_cast(s16x4, __builtin_amdgcn_ds_read_tr16_b64_v4i16((LAS s16x4*)(p + 8)));
                const s16x4 hi1 = __builtin_bit_cast(s16x4, __builtin_amdgcn_ds_read_tr16_b64_v4i16((LAS s16x4*)(p + 4 * PITCH + 8)));
                const bf16x8 vf0 = __builtin_shufflevector(lo0, hi0, 0, 1, 2, 3, 4, 5, 6, 7), vf1 = __builtin_shufflevector(lo1, hi1, 0, 1, 2, 3, 4, 5, 6, 7);
                const bf16x8 a = ks == 0 ? af[0] : (ks == 1 ? af[1] : (ks == 2 ? af[2] : af[3]));
                acc0 = __builtin_amdgcn_mfma_f32_16x16x32_bf16(vf0, a, acc0, 0, 0, 0);
                acc1 = __builtin_amdgcn_mfma_f32_16x16x32_bf16(vf1, a, acc1, 0, 0, 0);
            }
            const u32x4 uv = uc[np];
            u32x4 o;
            o.x = pk2(bflo(uv.x) * (acc0[0] + bs), bfhi(uv.x) * (acc0[1] + bs)); o.y = pk2(bflo(uv.y) * (acc0[2] + bs), bfhi(uv.y) * (acc0[3] + bs));
            o.z = pk2(bflo(uv.z) * (acc1[0] + bs), bfhi(uv.z) * (acc1[1] + bs)); o.w = pk2(bflo(uv.w) * (acc1[2] + bs), bfhi(uv.w) * (acc1[3] + bs));
            *(u32x4*)(Uo + grow + 32 * np) = o;
        }
    }
#undef GATE_STATS
#undef GATE_LOAD
}

__device__ __forceinline__ void attn_phase(Frame& F, bf16* Oo) {
    const int tid = F.tid, lane = F.lane, w = F.wave, i16 = lane & 15, quad = lane >> 4;
    constexpr int PITCH = 144, KROWS = 272;
    LAS unsigned char* KS = F.lds; LAS unsigned char* VS = F.lds + KROWS * PITCH;
    const bf16* Kb = WSP(bf16, WS_KB); const bf16* Vb = WSP(bf16, WS_VB); const bf16* Q = WSP(bf16, WS_Q);
    constexpr float LOG2E = 1.44269504089f, NEG = -1.0e30f;
    u32x4 kreg[5], vreg[5];
    auto load_kv = [&](int u) {
        const int b = u >> 7, qb = (u >> 2) & 31, kvh = u & 3;
#pragma unroll
        for (int i = 0; i < 5; ++i) { const int idx = tid + NTHR * i, rr = idx >> 3, chk = idx & 7; const int kp = (qb - 1) * 128 + rr;
            kreg[i] = (u32x4){0u, 0u, 0u, 0u}; vreg[i] = kreg[i];
            if (idx < KROWS * 8 && rr < 256 && kp >= 0) { const size_t off = (size_t)(b * SEQ + kp) * (4 * HD) + kvh * HD + chk * 8; kreg[i] = *(const u32x4*)(Kb + off); vreg[i] = *(const u32x4*)(Vb + off); } }
    };
    int u = F.bid;
    if (u < 512) load_kv(u);
    for (; u < 512; u += F.G) {
        const int b = u >> 7, qb = (u >> 2) & 31, kvh = u & 3;
        __syncthreads();
#pragma unroll
        for (int i = 0; i < 5; ++i) { const int idx = tid + NTHR * i, rr = idx >> 3, chk = idx & 7;
            if (idx < KROWS * 8) { *(LAS u32x4*)(KS + rr * PITCH + chk * 16) = kreg[i]; *(LAS u32x4*)(VS + rr * PITCH + chk * 16) = vreg[i]; } }
        __syncthreads();
        if (u + F.G < 512) load_kv(u + F.G);
        const int h = kvh * 8 + w; const float sink = F.in[16][h];
        const size_t qbase = (size_t)(b * SEQ + qb * 128 + i16) * D + h * HD + 8 * quad;
        bf16x8 qn0 = *(const bf16x8*)(Q + qbase), qn1 = *(const bf16x8*)(Q + qbase + 32);
#pragma unroll 2
        for (int mt = 0; mt < 8; ++mt) {
            const bf16x8 qf0 = qn0, qf1 = qn1;
            if (mt < 7) { qn0 = *(const bf16x8*)(Q + qbase + (size_t)(16 * (mt + 1)) * D); qn1 = *(const bf16x8*)(Q + qbase + (size_t)(16 * (mt + 1)) * D + 32); }
            f32x4 st[9];
#pragma unroll
            for (int kt = 0; kt < 9; ++kt) { st[kt] = (f32x4){0.f, 0.f, 0.f, 0.f};
                const LAS unsigned char* kp = KS + (16 * (mt + kt) + i16) * PITCH + 16 * quad;
                st[kt] = __builtin_amdgcn_mfma_f32_16x16x32_bf16(*(const LAS bf16x8*)kp, qf0, st[kt], 0, 0, 0);
                st[kt] = __builtin_amdgcn_mfma_f32_16x16x32_bf16(*(const LAS bf16x8*)(kp + 64), qf1, st[kt], 0, 0, 0); }
#pragma unroll
            for (int j = 0; j < 4; ++j) { st[0][j] = (i16 < 4 * quad + j) ? st[0][j] : NEG; st[8][j] = (i16 >= 4 * quad + j) ? st[8][j] : NEG; }
            if (qb == 0) {
#pragma unroll
                for (int kt = 0; kt < 8; ++kt) if (mt + kt < 8) st[kt] = (f32x4){NEG, NEG, NEG, NEG};
            }
            float mx = sink;
#pragma unroll
            for (int kt = 0; kt < 9; ++kt) mx = fmaxf(fmaxf(mx, fmaxf(st[kt][0], st[kt][1])), fmaxf(st[kt][2], st[kt][3]));
            mx = fmaxf(mx, __shfl_xor(mx, 16)); mx = fmaxf(mx, __shfl_xor(mx, 32));
            const float mxs = mx * LOG2E; float sum = 0.f;
#pragma unroll
            for (int kt = 0; kt < 9; ++kt)
#pragma unroll
                for (int j = 0; j < 4; ++j) { const float pv_ = fast_exp2(st[kt][j] * LOG2E - mxs); st[kt][j] = pv_; sum += pv_; }
            sum += __shfl_xor(sum, 16); sum += __shfl_xor(sum, 32);
            const float inv = 1.0f / (sum + fast_exp2(sink * LOG2E - mxs));
            f32x4 o[4];
#pragma unroll
            for (int dt = 0; dt < 4; ++dt) o[dt] = (f32x4){0.f, 0.f, 0.f, 0.f};
#pragma unroll
            for (int kk = 0; kk < 5; ++kk) {
                u32x4 pw; pw.x = cvt_pk_bf16(st[2 * kk][0], st[2 * kk][1]); pw.y = cvt_pk_bf16(st[2 * kk][2], st[2 * kk][3]);
                if (kk < 4) { pw.z = cvt_pk_bf16(st[2 * kk + 1][0], st[2 * kk + 1][1]); pw.w = cvt_pk_bf16(st[2 * kk + 1][2], st[2 * kk + 1][3]); } else { pw.z = 0u; pw.w = 0u; }
                const bf16x8 pf = __builtin_bit_cast(bf16x8, pw);
#pragma unroll
                for (int dt = 0; dt < 4; ++dt) {
                    const LAS unsigned char* p = VS + (16 * (mt + 2 * kk) + 4 * quad + (i16 >> 2)) * PITCH + (16 * dt + 4 * (i16 & 3)) * 2;
                    const s16x4 lo = __builtin_bit_cast(s16x4, __builtin_amdgcn_ds_read_tr16_b64_v4i16((LAS s16x4*)p));
                    const s16x4 hi = __builtin_bit_cast(s16x4, __builtin_amdgcn_ds_read_tr16_b64_v4i16((LAS s16x4*)(p + 16 * PITCH)));
                    const bf16x8 vf = __builtin_shufflevector(lo, hi, 0, 1, 2, 3, 4, 5, 6, 7);
                    o[dt] = __builtin_amdgcn_mfma_f32_16x16x32_bf16(vf, pf, o[dt], 0, 0, 0);
                }
            }
            const size_t qrow = (size_t)(b * SEQ + qb * 128 + 16 * mt + i16);
#pragma unroll
            for (int dt = 0; dt < 4; ++dt) { const f32x4 r = o[dt] * inv; *(u32x2*)(Oo + qrow * D + h * HD + 16 * dt + 4 * quad) = (u32x2){cvt_pk_bf16(r[0], r[1]), cvt_pk_bf16(r[2], r[3])}; }
        }
    }
}

__device__ __forceinline__ void scatter_phase(Frame& F) {
    const int tid = F.tid, lane = F.lane, w = F.wave;
    volatile LAS int* CN = (volatile LAS int*)F.lds;
    volatile LAS int* NEe = CN + 2048;
    volatile LAS int* BASE = NEe + 8;
    volatile LAS int* OFFS = BASE + 8;
    volatile LAS int* SL = OFFS + 8;
    const int* cnt = (const int*)F.ctl + CW_CNT;
    __syncthreads();
    for (int i = tid; i < 2048; i += NTHR) CN[i] = cnt[i];
    __syncthreads();
    { int n = 0;
#pragma unroll
      for (int q = 0; q < 4; ++q) n += CN[(lane + 64 * q) * 8 + w];
      n = (int)wave_sum((float)n); if (lane == 0) NEe[w] = n; }
    __syncthreads();
    if (tid == 0) { int tb = 0; for (int e = 0; e < 8; ++e) { BASE[e] = tb * 256; if (F.bid == 0) { ((int*)F.ctl)[CW_META + e] = NEe[e]; ((int*)F.ctl)[CW_META + 8 + e] = tb; } tb += (NEe[e] + 255) >> 8; }
        if (F.bid == 0) { ((int*)F.ctl)[CW_META + 16] = tb; ((int*)F.ctl)[CW_META + 17] = tb; } }
    __syncthreads();
    const bf16* H = WSP(bf16, WS_H); unsigned char* AS = WSP(unsigned char, WS_AS);
    for (int vb = F.bid; vb < 256; vb += F.G) {
        __syncthreads();
        { int n = 0;
#pragma unroll
          for (int q = 0; q < 4; ++q) { const int b = lane + 64 * q; n += (b < vb) ? CN[b * 8 + w] : 0; }
          n = (int)wave_sum((float)n); if (lane == 0) OFFS[w] = n; }
        __syncthreads();
        if (w == 0) {
            const int tok = vb * 64 + lane; const int ee = WSP(int, WS_TOKE)[tok]; const int e1 = ee & 0xff, e2 = (ee >> 8) & 0xff;
            const unsigned long long lt = (1ull << lane) - 1ull;
            int s1 = 0, s2 = 0;
#pragma unroll
            for (int e = 0; e < 8; ++e) { const unsigned long long m1 = __ballot(e1 == e), m2 = __ballot(e2 == e); const int base = BASE[e] + OFFS[e];
                if (e1 == e) s1 = base + __popcll(m1 & lt); if (e2 == e) s2 = base + __popcll(m1) + __popcll(m2 & lt); }
            WSP(int, WS_SLOT)[2 * tok] = s1; WSP(int, WS_SLOT)[2 * tok + 1] = s2; SL[2 * lane] = s1; SL[2 * lane + 1] = s2;
        }
        __syncthreads();
        if (tid < 128) WSP(unsigned, WS_TOKOF)[SL[tid]] = (unsigned)(vb * 64 + (tid >> 1));
        if (vb < 8) { const int n = NEe[vb], first = BASE[vb] + n, end = BASE[vb] + (((n + 255) >> 8) << 8);
            for (int r = first + tid; r < end; r += NTHR) WSP(unsigned, WS_TOKOF)[r] = 0u; }
    }
}

__device__ __forceinline__ void combine_phase(Frame& F, float* outp) {
    const int lane = F.lane; const int gw = F.bid * NWAVES + F.wave, NGW = F.G * NWAVES;
    const bf16* OE = WSP(bf16, WS_OE);
    for (int row = gw; row < M; row += NGW) {
        const int b = row / SEQ; const float* g2 = WSP(float, WS_MOD) + (size_t)(1 * NB + b) * (6 * D) + 5 * D;
        const int s1 = WSP(int, WS_SLOT)[2 * row], s2 = WSP(int, WS_SLOT)[2 * row + 1]; const f32x2 tw = WSP(f32x2, WS_TOKW)[row];
        const u32x4* p1 = (const u32x4*)(OE + (size_t)s1 * D) + lane; const u32x4* p2 = (const u32x4*)(OE + (size_t)s2 * D) + lane;
        const bool t1 = s1 >= MAIN_TILES * 256, t2 = s2 >= MAIN_TILES * 256; const float* TPp = WSP(float, WS_TP);
        const bf16* irow = WSP(bf16, WS_XB) + (size_t)row * D; float* orow = outp + (size_t)row * D;
#pragma unroll
        for (int j = 0; j < 4; ++j) { const u32x4 a = p1[64 * j], c = p2[64 * j]; const int col = 8 * (64 * j + lane);
            const u32x4 xw = *(const u32x4*)(irow + col); const f32x4 x0 = (f32x4){bflo(xw.x), bfhi(xw.x), bflo(xw.y), bfhi(xw.y)}, x1 = (f32x4){bflo(xw.z), bfhi(xw.z), bflo(xw.w), bfhi(xw.w)}, g0 = *(const f32x4*)(g2 + col), g1 = *(const f32x4*)(g2 + col + 4);
            f32x4 a0 = (f32x4){bflo(a.x), bfhi(a.x), bflo(a.y), bfhi(a.y)}, a1 = (f32x4){bflo(a.z), bfhi(a.z), bflo(a.w), bfhi(a.w)};
            f32x4 c0 = (f32x4){bflo(c.x), bfhi(c.x), bflo(c.y), bfhi(c.y)}, c1 = (f32x4){bflo(c.z), bfhi(c.z), bflo(c.w), bfhi(c.w)};
            if (t1) { a0 = (f32x4){0.f, 0.f, 0.f, 0.f}; a1 = a0;
#pragma unroll
                for (int ks = 0; ks < TAIL_KSPLIT; ++ks) { const float* q = TPp + ((size_t)ks * TAIL_ROWS + (s1 - MAIN_TILES * 256)) * D + col; a0 += *(const f32x4*)q; a1 += *(const f32x4*)(q + 4); } }
            if (t2) { c0 = (f32x4){0.f, 0.f, 0.f, 0.f}; c1 = c0;
#pragma unroll
                for (int ks = 0; ks < TAIL_KSPLIT; ++ks) { const float* q = TPp + ((size_t)ks * TAIL_ROWS + (s2 - MAIN_TILES * 256)) * D + col; c0 += *(const f32x4*)q; c1 += *(const f32x4*)(q + 4); } }
            const f32x4 y0 = a0 * tw.x + c0 * tw.y, y1 = a1 * tw.x + c1 * tw.y;
            *(f32x4*)(orow + col) = x0 + g0 * y0; *(f32x4*)(orow + col + 4) = x1 + g1 * y1; }
    }
}

constexpr int NPHASE = 17;
struct Args { const float* in[24]; float* out; unsigned char* ws; int ph_lo, ph_hi; };
__global__ void __launch_bounds__(NTHR, 2) mk_fwd(Args args) {
    extern __shared__ __attribute__((aligned(16))) unsigned char lds[];
    Frame F;
    F.lds = (LAS unsigned char*)lds; F.MISC = (volatile LAS unsigned*)(F.lds + MISC_OFF);
    F.tid = threadIdx.x; F.lane = F.tid & 63; F.wave = __builtin_amdgcn_readfirstlane(F.tid >> 6); F.G = gridDim.x; F.bid = blockIdx.x;
    F.ws = args.ws; F.ctl = (unsigned*)(args.ws + WS_CTL); F.out = args.out;
#pragma unroll
    for (int i = 0; i < 24; ++i) F.in[i] = args.in[i];
    for (int u = F.tid; u < (LDS_BYTES - MISC_OFF) / 4; u += NTHR) ((LAS unsigned*)(F.lds + MISC_OFF))[u] = 0u;
    __syncthreads();
    XcdBarrier bar; bar.bar = F.ctl + CW_BAR; bar.x = 0; bar.st = nullptr;
    if (!MK_PER_PHASE) bar = xcd_barrier_post(F.ctl + CW_BAR, F.MISC + 8);
    const int lo = args.ph_lo, hi = args.ph_hi;
#define IN(k) (lo <= (k) && (k) < hi)
#define SEAM(k) do { if (IN(k) && IN((k) + 1)) xcd_barrier(bar); } while (0)
    const float* MOD = WSP(float, WS_MOD);
    const bool grpA = (F.bid & 7) < 4;
#define CONV_PRE(lo_, hi_) do { if (grpA) { convert_items(F, lo_, hi_, F.bid * NWAVES + F.wave, F.G * NWAVES); __syncthreads(); } } while (0)
#define CONV_POST(lo_, hi_) do { if (!grpA) convert_items(F, lo_, hi_, F.bid * NWAVES + F.wave, F.G * NWAVES); } while (0)
    volatile LAS int* TB = (volatile LAS int*)(F.lds + MISC_OFF + 256);

    if (IN(0)) { for (int r_ = 0; r_ < (PROBE_DUP == 0 ? 2 : 1); ++r_) { p0_prologue(F); __syncthreads(); } } SEAM(0);
    if (IN(1)) { for (int r_ = 0; r_ < (PROBE_DUP == 1 ? 2 : 1); ++r_) norm_phase<false>(F, F.in[0], 0, 0); } SEAM(1);
    if (IN(2)) { CONV_PRE(CV_B0, CV_B1); pg8::Gemm g{WSP(bf16, WS_H), WSP(bf16, WS_WIN), 2 * D, 0, 0, nullptr}; pg8::Order S; S.init(M / 256, NIN / 256, F.G, F.bid, nullptr);
        pg8::EpiGelu E{WSP(bf16, WS_U), WSP(bf16, WS_V), F.in[7], WSP(f32x2, WS_VST)}; pg8::gemm_phase(F.lds, g, S, E);  CONV_POST(CV_B0, CV_B1); } SEAM(2);
    if (IN(3)) { if (PROBE_DUP == 3) gate_phase(F, WSP(bf16, WS_FFH)); gate_phase(F, WSP(bf16, WS_U)); } SEAM(3);
    if (IN(4)) { CONV_PRE(CV_B1, CV_B2); pg8::Gemm g{WSP(bf16, WS_U), WSP(bf16, WS_WOUT), 2 * GW, 0, 0, nullptr}; pg8::Order S; S.init(M / 256, D / 256, F.G, F.bid, nullptr);
        pg8::EpiResB<true> E{F.in[0], WSP(bf16, WS_XB), MOD + 2 * D, 1.f}; pg8::gemm_phase(F.lds, g, S, E);  CONV_POST(CV_B1, CV_B2); } SEAM(4);
    if (IN(5)) { norm_phase<false, true>(F, WSP(float, WS_XB), 0, 1); } SEAM(5);
    if (IN(6)) { CONV_PRE(CV_B2, CV_B3); pg8::Gemm g{WSP(bf16, WS_H), WSP(bf16, WS_WGU), 2 * D, 0, 0, nullptr}; pg8::Order S; S.init(M / 256, 2 * FF / 256, F.G, F.bid, nullptr);
        pg8::EpiSwiglu8 E{WSP(unsigned char, WS_FFH), FF, 1.0f, SC_HID}; pg8::gemm_phase(F.lds, g, S, E);  CONV_POST(CV_B2, CV_B3); } SEAM(6);
    if (IN(7)) { CONV_PRE(CV_B3, CV_B4); pg8::Gemm g{WSP(unsigned char, WS_FFH), WSP(unsigned char, WS_WD), FF, 0, 0, nullptr}; pg8::Order S; S.init(M / 256, D / 256, F.G, F.bid, nullptr);
        pg8::EpiResB<false> E{nullptr, WSP(bf16, WS_XB), MOD + 5 * D, 1.0f / (SC_HID * SC_W)}; pg8::gemm_phase<pg8::EpiResB<false>, true>(F.lds, g, S, E);  CONV_POST(CV_B3, CV_B4); } SEAM(7);
    if (IN(8)) { norm_phase<false, true>(F, WSP(float, WS_XB), 1, 0); } SEAM(8);
    const bool p9all = F.G != 256, p9two = F.bid >= 128;
    if (IN(9)) { if (p9all) CONV_PRE(CV_B4, CV_B5); else if (p9two && grpA) { convert_items(F, CV_B4, CV_B5, (F.bid - 128) * NWAVES + F.wave, 128 * NWAVES); __syncthreads(); }
        pg8::Gemm g{WSP(bf16, WS_H), WSP(bf16, WS_WQKV), 2 * D, 0, 0, nullptr}; pg8::Order S; S.init(M / 256, NQKV / 256, F.G, F.bid, nullptr);
        pg8::EpiQKV E{WSP(bf16, WS_Q), WSP(bf16, WS_KB), WSP(bf16, WS_VB), F.in[14], F.in[15], WSP(float, WS_CS)}; pg8::gemm_phase(F.lds, g, S, E);
        if (p9all) CONV_POST(CV_B4, CV_B5); else if (p9two && !grpA) convert_items(F, CV_B4, CV_B5, (F.bid - 128) * NWAVES + F.wave, 128 * NWAVES); } SEAM(9);
    if (IN(10)) { if (PROBE_DUP == 10) attn_phase(F, WSP(bf16, WS_FFH)); attn_phase(F, WSP(bf16, WS_Q)); } SEAM(10);
    if (IN(11)) { CONV_PRE(CV_B5, CV_B6); pg8::Gemm g{WSP(bf16, WS_Q), WSP(bf16, WS_WO), 2 * D, 0, 0, nullptr}; pg8::Order S; S.init(M / 256, D / 256, F.G, F.bid, nullptr);
        pg8::EpiResB<false> E{nullptr, WSP(bf16, WS_XB), MOD + (size_t)NB * 6 * D + 2 * D, 1.f}; pg8::gemm_phase(F.lds, g, S, E);  CONV_POST(CV_B5, CV_B6); } SEAM(11);
    if (IN(12)) { norm_phase<true, true>(F, WSP(float, WS_XB), 1, 1); } SEAM(12);
    if (IN(13)) { for (int r_ = 0; r_ < (PROBE_DUP == 13 ? 2 : 1); ++r_) scatter_phase(F); } SEAM(13);
    if (IN(14) || IN(15)) { __syncthreads(); if (F.tid < 9) TB[F.tid] = ((const int*)F.ctl)[CW_META + 8 + F.tid]; __syncthreads(); }
    if (IN(14)) { const int nT = __builtin_amdgcn_readfirstlane(TB[8]); pg8::Gemm g{WSP(unsigned char, WS_H), WSP(unsigned char, WS_MWGU), D, (size_t)2 * FFE * D, 0, WSP(unsigned, WS_TOKOF)}; pg8::Order S; S.init(nT, 2 * FFE / 256, F.G, F.bid, TB);
        pg8::EpiSwiglu8 E{WSP(unsigned char, WS_HID), FFE, 1.0f / (SC_H * SC_W), SC_HID}; pg8::gemm_phase<pg8::EpiSwiglu8, true, PG8_ALIGN, true>(F.lds, g, S, E); } SEAM(14);
    if (IN(15)) { const int nT = __builtin_amdgcn_readfirstlane(TB[8]);
        if (nT > MAIN_TILES) { pg8::Gemm g{WSP(unsigned char, WS_HID), WSP(unsigned char, WS_MWD), FFE, (size_t)D * FFE, FFE / 128 / TAIL_KSPLIT, nullptr}; pg8::Order S; S.init_tail(MAIN_TILES, nT - MAIN_TILES, D / 256, TAIL_KSPLIT, FFE / TAIL_KSPLIT, F.G, F.bid, TB);
          pg8::EpiPart E{WSP(float, WS_TP), MAIN_TILES * 256, TAIL_ROWS, FFE / TAIL_KSPLIT, 1.0f / (SC_HID * SC_W)}; pg8::gemm_phase<pg8::EpiPart, true>(F.lds, g, S, E); }
        { pg8::Gemm g{WSP(unsigned char, WS_HID), WSP(unsigned char, WS_MWD), FFE, (size_t)D * FFE, 0, nullptr}; pg8::Order S; S.init(nT < MAIN_TILES ? nT : MAIN_TILES, D / 256, F.G, F.bid, TB);
          pg8::EpiBf16 E{WSP(bf16, WS_OE), D, 1.0f / (SC_HID * SC_W)}; pg8::gemm_phase<pg8::EpiBf16, true>(F.lds, g, S, E); } } SEAM(15);
    if (IN(16)) { if (PROBE_DUP == 16) combine_phase(F, WSP(float, WS_U)); combine_phase(F, F.out); }
#undef IN
#undef SEAM
}

extern "C" void kernel_launch(void* const* d_in, const int* in_sizes, int n_in, void* d_out, int out_size, void* d_ws, size_t ws_size, hipStream_t stream) {
    static int grid = 0;
    if (grid == 0) {
        if (n_in != 24 || out_size != M * D || ws_size < WS_END) { fprintf(stderr, "kernel_launch: unexpected problem (n_in %d, out %d, ws %zu); nothing launched\n", n_in, out_size, ws_size); grid = -1; return; }
        int dev = 0, cus = 0, per_cu = 0;
        if (hipGetDevice(&dev) != hipSuccess || hipDeviceGetAttribute(&cus, hipDeviceAttributeMultiprocessorCount, dev) != hipSuccess) { grid = -1; return; }
        if (hipFuncSetAttribute((const void*)mk_fwd, hipFuncAttributeMaxDynamicSharedMemorySize, LDS_BYTES) != hipSuccess) { fprintf(stderr, "kernel_launch: hipFuncSetAttribute failed\n"); grid = -1; return; }
        if (hipOccupancyMaxActiveBlocksPerMultiprocessor(&per_cu, (const void*)mk_fwd, NTHR, LDS_BYTES) != hipSuccess || per_cu < 1) fprintf(stderr, "kernel_launch: occupancy query reports %d\n", per_cu);
        (void)hipGetLastError();
        grid = cus > 256 ? 256 : cus;
    }
    if (grid < 0) return;
    (void)hipMemsetAsync((char*)d_ws + WS_CTL, 0, CTL_ZERO_BYTES, stream);
    Args a{};
    for (int i = 0; i < 24; ++i) a.in[i] = (const float*)d_in[i];
    a.out = (float*)d_out; a.ws = (unsigned char*)d_ws;
#if MK_PER_PHASE
    for (int p = 0; p < NPHASE; ++p) { a.ph_lo = p; a.ph_hi = p + 1; hipLaunchKernelGGL(mk_fwd, dim3(grid), dim3(NTHR), LDS_BYTES, stream, a); }
#else
    a.ph_lo = 0; a.ph_hi = NPHASE; hipLaunchKernelGGL(mk_fwd, dim3(grid), dim3(NTHR), LDS_BYTES, stream, a);
#endif
}
```

```cpp
#include <hip/hip_runtime.h>
#include <cstdio>
#include <cstdint>

#ifndef MK_PER_PHASE
#define MK_PER_PHASE 0
#endif

#ifndef PROBE_DUP
#define PROBE_DUP -1
#endif
#define GAS __attribute__((address_space(1)))
#define LAS __attribute__((address_space(3)))
typedef unsigned short bf16;
typedef short bf16x8 __attribute__((ext_vector_type(8)));
typedef short s16x4 __attribute__((ext_vector_type(4)));
typedef float f32x4 __attribute__((ext_vector_type(4)));
typedef float f32x2 __attribute__((ext_vector_type(2)));
typedef unsigned u32x4 __attribute__((ext_vector_type(4)));
typedef unsigned u32x2 __attribute__((ext_vector_type(2)));
typedef int i32x4 __attribute__((ext_vector_type(4)));
typedef int i32x8 __attribute__((ext_vector_type(8)));

constexpr int D = 2048, NB = 4, SEQ = 4096, M = NB * SEQ;
constexpr int GW = 4096, NIN = 2 * GW;
constexpr int FF = 5632, FFE = 7168, NE = 8;
constexpr int NQKV = 2560, HD = 64;
constexpr int SLOTS = 2 * M + NE * 256;
constexpr float EPS = 1e-6f;

constexpr size_t MiB = 1u << 20;
constexpr size_t WS_CTL = 0, CTL_ZERO_BYTES = 1 * MiB;
constexpr size_t WS_MOD = 1 * MiB;
constexpr size_t WS_CS = 2 * MiB;
constexpr size_t WS_WSB = 3 * MiB;
constexpr size_t WS_TOKE = 4 * MiB;
constexpr size_t WS_TOKW = WS_TOKE + 64 * 1024;
constexpr size_t WS_SLOT = WS_TOKW + 128 * 1024;
constexpr size_t WS_TOKOF = 5 * MiB;
constexpr size_t WS_VST = 8 * MiB;
constexpr size_t WS_WIN = 16 * MiB, WS_WOUT = 48 * MiB, WS_WGU = 64 * MiB, WS_WD = 108 * MiB, WS_WQKV = 130 * MiB, WS_WO = 140 * MiB;
constexpr size_t WS_MWGU = 148 * MiB, WS_MWD = 596 * MiB;
constexpr size_t WS_H = 820 * MiB, WS_U = 884 * MiB, WS_V = 1012 * MiB, WS_FFH = 1140 * MiB, WS_Q = 1316 * MiB, WS_KB = 1380 * MiB, WS_VB = 1388 * MiB;
constexpr size_t WS_XB = 1396 * MiB;
constexpr size_t WS_AS = 1396 * MiB, WS_HID = 1532 * MiB, WS_OE = 2008 * MiB, WS_TP = 2144 * MiB, WS_END = 2208 * MiB;
constexpr int MAIN_TILES = 2 * M / 256, TAIL_KSPLIT = 4, TAIL_ROWS = NE * 256;
static_assert(WS_AS + (size_t)SLOTS * D * 2 <= WS_HID && WS_HID + (size_t)SLOTS * FFE * 2 <= WS_OE && WS_OE + (size_t)SLOTS * D * 2 <= WS_TP && WS_TP + (size_t)TAIL_KSPLIT * TAIL_ROWS * D * 4 <= WS_END, "ws map");
static_assert(WS_FFH + (size_t)M * FF * 2 <= WS_Q && WS_MWGU + (size_t)NE * 2 * FFE * D * 2 <= WS_MWD && WS_MWD + (size_t)NE * D * FFE * 2 <= WS_H, "ws map");
constexpr int CW_BAR = 4096;
constexpr int CW_CNT = 16384;
constexpr int CW_META = 16384 + 2048;

constexpr int RING_BYTES = 131072;
constexpr int MISC_OFF = RING_BYTES;
constexpr int LDS_BYTES = 147456;
constexpr int NWAVES = 8, NTHR = 512;

#define RLX_AGENT __ATOMIC_RELAXED, __HIP_MEMORY_SCOPE_AGENT
#define LDS_WAIT() asm volatile("s_waitcnt lgkmcnt(0)" ::: "memory")
#define VM_WAIT() asm volatile("s_waitcnt vmcnt(0)" ::: "memory")
__device__ __forceinline__ unsigned f2bf(float f) { unsigned u = __builtin_bit_cast(unsigned, f); return (u + 0x7fffu + ((u >> 16) & 1u)) >> 16; }
__device__ __forceinline__ unsigned pk2(float lo, float hi) { return f2bf(lo) | (f2bf(hi) << 16); }
__device__ __forceinline__ float bf2f(unsigned short b) { return __builtin_bit_cast(float, (unsigned)b << 16); }
__device__ __forceinline__ float bflo(unsigned w) { return __builtin_bit_cast(float, w << 16); }
__device__ __forceinline__ float bfhi(unsigned w) { return __builtin_bit_cast(float, w & 0xffff0000u); }
__device__ __forceinline__ unsigned cvt_pk_bf16(float lo, float hi) { unsigned r; asm volatile("v_cvt_pk_bf16_f32 %0, %1, %2" : "=v"(r) : "v"(lo), "v"(hi)); return r; }
__device__ __forceinline__ float wave_sum(float v) {
#pragma unroll
    for (int o = 1; o < 64; o <<= 1) v += __shfl_xor(v, o);
    return v;
}
__device__ __forceinline__ float fast_exp2(float x) { return __builtin_amdgcn_exp2f(x); }
__device__ __forceinline__ float fast_rcp(float x) { return __builtin_amdgcn_rcpf(x); }
__device__ __forceinline__ unsigned pk4_fp8(float a, float b, float c, float d) {
    a = __builtin_amdgcn_fmed3f(a, -448.f, 448.f); b = __builtin_amdgcn_fmed3f(b, -448.f, 448.f); c = __builtin_amdgcn_fmed3f(c, -448.f, 448.f); d = __builtin_amdgcn_fmed3f(d, -448.f, 448.f);
    unsigned w = 0; w = __builtin_amdgcn_cvt_pk_fp8_f32(a, b, w, false); w = __builtin_amdgcn_cvt_pk_fp8_f32(c, d, w, true); return w;
}
constexpr float SC_H = 16.f, SC_W = 512.f, SC_HID = 4.f;
__device__ __forceinline__ float silu_f(float g) { return g * fast_rcp(1.0f + fast_exp2(-1.44269504089f * g)); }

#define XB_TMO      128
#define XB_XCNT(j)  (256  + 64 * (j))
#define XB_XSUB(j)  (1280 + 64 * (j))
#define XB_XGEN(j)  (2304 + 64 * (j))
#define XB_TOP      3328
#define XB_TOPGEN   3392
#define XCD_BAR_WORDS 3456
#define XB_SPIN_CAP (1u << 18)
__device__ __forceinline__ unsigned xb_ld(unsigned* p)              { return __hip_atomic_load(p, __ATOMIC_RELAXED, __HIP_MEMORY_SCOPE_AGENT); }
__device__ __forceinline__ unsigned xb_add(unsigned* p, unsigned v) { return __hip_atomic_fetch_add(p, v, __ATOMIC_RELAXED, __HIP_MEMORY_SCOPE_AGENT); }
__device__ __forceinline__ unsigned xb_xcc_id() { return (unsigned)__builtin_amdgcn_s_getreg((3 << 11) | 20) & 0xFu; }
#define XB_SPIN(cond, bar) do { unsigned _sp = 0; while (cond) { __builtin_amdgcn_s_sleep(1); \
    if ((++_sp & 255u) == 0u) { if (xb_ld(&(bar)[XB_TMO])) break; if (_sp > XB_SPIN_CAP) { atomicAdd(&(bar)[XB_TMO], 1u); break; } } } } while (0)
struct XcdBarrier { unsigned* bar; unsigned x; volatile LAS unsigned* st; };
__device__ __forceinline__ XcdBarrier xcd_barrier_post(unsigned* bar, volatile LAS unsigned* st) {
    XcdBarrier b; b.bar = bar; b.x = xb_xcc_id(); b.st = st;
    if (threadIdx.x == 0) (void)xb_add(&bar[XB_XCNT(b.x)], 1u);
    return b;
}
__device__ __forceinline__ void xcd_barrier_complete(unsigned* bar, unsigned x, unsigned& nloc, unsigned& nx) {
    const unsigned G = gridDim.x * gridDim.y * gridDim.z;
    unsigned sum, cnt, mine, sp = 0u;
    for (;;) {
        sum = 0u; cnt = 0u; mine = 0u;
#pragma unroll
        for (unsigned j = 0; j < 16; ++j) { const unsigned c = xb_ld(&bar[XB_XCNT(j)]); sum += c; cnt += (c > 0u) ? 1u : 0u; mine = (j == x) ? c : mine; }
        if (sum == G) break;
        __builtin_amdgcn_s_sleep(1);
        if ((++sp & 255u) == 0u) { if (xb_ld(&bar[XB_TMO])) break; if (sp > XB_SPIN_CAP) { atomicAdd(&bar[XB_TMO], 1u); break; } }
    }
    nloc = mine > 0u ? mine : 1u; nx = cnt > 0u ? cnt : 1u;
}
__device__ __forceinline__ void xcd_barrier(const XcdBarrier& b) {
    asm volatile("s_waitcnt vmcnt(0)" ::: "memory");
    __syncthreads();
    if (threadIdx.x == 0) {
        unsigned* bar = b.bar;
        __builtin_amdgcn_s_waitcnt(0);
        unsigned nloc = b.st[0], nx = b.st[1];
        if (nloc == 0u) { xcd_barrier_complete(bar, b.x, nloc, nx); b.st[0] = nloc; b.st[1] = nx; }
        const unsigned old = xb_add(&bar[XB_XSUB(b.x)], 1u);
        const unsigned gen = old / nloc;
        if (old + 1u == (gen + 1u) * nloc) {
            __builtin_amdgcn_fence(__ATOMIC_RELEASE, "agent");
            asm volatile("s_waitcnt vmcnt(0)" ::: "memory");
            const unsigned og = xb_add(&bar[XB_TOP], 1u);
            const unsigned tg = og / nx;
            if (og + 1u == (tg + 1u) * nx) xb_add(&bar[XB_TOPGEN], 1u);
            else XB_SPIN(xb_ld(&bar[XB_TOPGEN]) == tg, bar);
            __builtin_amdgcn_fence(__ATOMIC_ACQUIRE, "agent");
            xb_add(&bar[XB_XGEN(b.x)], 1u);
            asm volatile("s_waitcnt vmcnt(0)" ::: "memory");
        } else {
            XB_SPIN(xb_ld(&bar[XB_XGEN(b.x)]) == gen, bar);
            __builtin_amdgcn_fence(__ATOMIC_ACQUIRE, "agent");
            asm volatile("s_waitcnt vmcnt(0)" ::: "memory");
        }
    }
    __syncthreads();
}

namespace pg8 {
constexpr int BM = 256, BK = 64, HALF = 128, HTB = HALF * BK * 2, STAGE_BYTES = 8 * HTB, NXCD = 8, WGM = 8;
__host__ __device__ __forceinline__ int lds_byte(int r, int c) { const int st = (r >> 4) * 2 + (c >> 5), rr = r & 15, cc = c & 31, ob = rr * 64 + cc * 2; return st * 1024 + (ob ^ (((ob >> 9) & 1) << 5)); }
__host__ __device__ __forceinline__ void stage_rc(int b, int& R, int& C) { const int st = b / 1024, sb = b % 1024, swz = sb ^ (((sb >> 9) & 1) << 5); R = (st >> 1) * 16 + swz / 64; C = (st & 1) * 32 + (swz % 64) / 2; }
__host__ __device__ __forceinline__ int perm32(int rho) { const int n = rho >> 4, i = rho & 15; return 8 * (i >> 2) + 4 * n + (i & 3); }

struct Unit { int pm, pn, eb, koff; };
struct Gemm { const void* A; const void* Bt; int rowbytes; size_t bstride; int ktiles; const unsigned* rowoff; };

struct Order {
    int nM, nN, nwg, G, c; const volatile LAS int* tb; int ksplit, kbytes, pm0;
    __device__ void init(int nM_, int nN_, int G_, int c_, const volatile LAS int* tb_) { nM = nM_; nN = nN_; nwg = nM * nN; G = G_; c = c_; tb = tb_; ksplit = 0; kbytes = 0; pm0 = 0; }
    __device__ void init_tail(int pm0_, int nMt, int nN_, int ksplit_, int kbytes_, int G_, int c_, const volatile LAS int* tb_) { nM = nMt; nN = nN_; nwg = nMt * nN_ * ksplit_; G = G_; c = c_; tb = tb_; ksplit = ksplit_; kbytes = kbytes_; pm0 = pm0_; }
    __device__ bool next(int i, Unit& u) const {
        const long L = (long)i * G + c; if (L >= nwg) return false;
        u.eb = 0; u.koff = 0;
        if (ksplit) { u.pm = pm0 + (int)(L / (nN * ksplit)); const int rem = (int)(L % (nN * ksplit)); u.pn = rem / ksplit; u.koff = (rem % ksplit) * kbytes; }
        else {
            int wgid = (int)L; { const int q = nwg / NXCD, r = nwg % NXCD, xcd = wgid % NXCD, off = wgid / NXCD; wgid = (xcd < r ? xcd * (q + 1) : r * (q + 1) + (xcd - r) * q) + off; }
            const int nig = WGM * nN, gid = wgid / nig, fm = gid * WGM, gsz = (nM - fm) < WGM ? (nM - fm) : WGM;
            u.pm = fm + ((wgid % nig) % gsz); u.pn = (wgid % nig) / gsz; }
        if (tb) { int e = 0;
#pragma unroll
            for (int j = 1; j < 8; ++j) e += (u.pm >= __builtin_amdgcn_readfirstlane(tb[j])) ? 1 : 0;
            u.eb = e; }
        return true;
    }
};

__device__ __forceinline__ f32x2 gelu_pk(f32x2 v) {
    const f32x2 av = __builtin_elementwise_abs(v), d = av * 0.2316418882f + 1.0f;
    f32x2 t; t.x = __builtin_amdgcn_rcpf(d.x); t.y = __builtin_amdgcn_rcpf(d.y);
    f32x2 q = t * 0.5307027145f + (-0.7265760135f); q = q * t + 0.7107068705f; q = q * t + (-0.142248368f); q = q * t + 0.127414796f; q = q * t;
    const f32x2 s = (v * v) * (-0.72134752044f);
    f32x2 e; e.x = __builtin_amdgcn_exp2f(s.x); e.y = __builtin_amdgcn_exp2f(s.y);
    const f32x2 m = v * (q * e), r = v - m;
    f32x2 o; o.x = v.x < 0.f ? m.x : r.x; o.y = v.y < 0.f ? m.y : r.y; return o;
}


struct EpiGelu {
    static constexpr bool PERM = true;
    bf16* U; bf16* V; const float* bias; f32x2* vst;
    __device__ __forceinline__ void operator()(const f32x4 (&acc)[2][2][4][2], const Unit& u, int wr, int wc, int fr, int fq) const {
        const bool isv = u.pn >= 16; bf16* base = isv ? V : U; const int colt = (u.pn & 15) * BM;
        const int row0 = u.pm * BM + wr * 64 + fr, col0 = colt + wc * 32 + 8 * fq, bcol0 = u.pn * BM + wc * 32 + 8 * fq;
        f32x4 bv[2][2];
#pragma unroll
        for (int bj = 0; bj < 2; ++bj)
#pragma unroll
            for (int n = 0; n < 2; ++n) bv[bj][n] = *(const f32x4*)(bias + bcol0 + bj * HALF + 4 * n);
#pragma unroll
        for (int ai = 0; ai < 2; ++ai)
#pragma unroll
            for (int m = 0; m < 4; ++m) { const int row = row0 + ai * HALF + m * 16; bf16* rowp = base + (size_t)row * GW + col0; float s = 0.f, q = 0.f;
#pragma unroll
                for (int bj = 0; bj < 2; ++bj) { f32x4 v0 = acc[ai][bj][m][0] + bv[bj][0], v1 = acc[ai][bj][m][1] + bv[bj][1];
                    { f32x2 a = gelu_pk((f32x2){v0[0], v0[1]}), b = gelu_pk((f32x2){v0[2], v0[3]}), c = gelu_pk((f32x2){v1[0], v1[1]}), d = gelu_pk((f32x2){v1[2], v1[3]});
                      v0 = (f32x4){a.x, a.y, b.x, b.y}; v1 = (f32x4){c.x, c.y, d.x, d.y}; }
                    s += (v0[0] + v0[1]) + (v0[2] + v0[3]) + (v1[0] + v1[1]) + (v1[2] + v1[3]);
                    q += (v0[0] * v0[0] + v0[1] * v0[1]) + (v0[2] * v0[2] + v0[3] * v0[3]) + (v1[0] * v1[0] + v1[1] * v1[1]) + (v1[2] * v1[2] + v1[3] * v1[3]);
                    u32x4 w; w.x = cvt_pk_bf16(v0[0], v0[1]); w.y = cvt_pk_bf16(v0[2], v0[3]); w.z = cvt_pk_bf16(v1[0], v1[1]); w.w = cvt_pk_bf16(v1[2], v1[3]);
                    *(u32x4*)(rowp + bj * HALF) = w; }
                if (isv) { s += __shfl_xor(s, 16); s += __shfl_xor(s, 32); q += __shfl_xor(q, 16); q += __shfl_xor(q, 32);
                    if (fq == 0) vst[(size_t)row * 64 + (u.pn - 16) * 4 + wc] = (f32x2){s, q}; } }
    }
};
struct EpiRes {
    static constexpr bool PERM = false;
    const float* base; float* out; const float* gate; float sc;
    __device__ __forceinline__ void operator()(const f32x4 (&acc)[2][2][4][2], const Unit& u, int wr, int wc, int fr, int fq) const {
        const int row0 = u.pm * BM + wr * 64 + fr, col0 = u.pn * BM + wc * 32 + 4 * fq; const float* gp = gate + (size_t)((u.pm * BM) / SEQ) * (6 * D) + col0;
        f32x4 gv[2][2];
#pragma unroll
        for (int bj = 0; bj < 2; ++bj)
#pragma unroll
            for (int n = 0; n < 2; ++n) gv[bj][n] = *(const f32x4*)(gp + bj * HALF + n * 16) * sc;
#pragma unroll
        for (int ai = 0; ai < 2; ++ai)
#pragma unroll
            for (int m = 0; m < 4; ++m) { const size_t off = (size_t)(row0 + ai * HALF + m * 16) * D + col0;
#pragma unroll
                for (int bj = 0; bj < 2; ++bj)
#pragma unroll
                    for (int n = 0; n < 2; ++n) { const f32x4 b = *(const f32x4*)(base + off + bj * HALF + n * 16); *(f32x4*)(out + off + bj * HALF + n * 16) = b + gv[bj][n] * acc[ai][bj][m][n]; } }
    }
};
template <bool B32>
struct EpiResB {
    static constexpr bool PERM = true;
    const float* base32; bf16* xb; const float* gate; float sc;
    __device__ __forceinline__ void operator()(const f32x4 (&acc)[2][2][4][2], const Unit& u, int wr, int wc, int fr, int fq) const {
        const int row0 = u.pm * BM + wr * 64 + fr, col0 = u.pn * BM + wc * 32 + 8 * fq; const float* gp = gate + (size_t)((u.pm * BM) / SEQ) * (6 * D) + col0;
        f32x4 gv[2][2];
#pragma unroll
        for (int bj = 0; bj < 2; ++bj)
#pragma unroll
            for (int n = 0; n < 2; ++n) gv[bj][n] = *(const f32x4*)(gp + bj * HALF + 4 * n) * sc;
#pragma unroll
        for (int ai = 0; ai < 2; ++ai)
#pragma unroll
            for (int m = 0; m < 4; ++m) { const size_t off = (size_t)(row0 + ai * HALF + m * 16) * D + col0;
#pragma unroll
                for (int bj = 0; bj < 2; ++bj) { f32x4 b0, b1;
                    if constexpr (B32) { b0 = *(const f32x4*)(base32 + off + bj * HALF); b1 = *(const f32x4*)(base32 + off + bj * HALF + 4); }
                    else { const u32x4 x = *(const u32x4*)(xb + off + bj * HALF); b0 = (f32x4){bflo(x.x), bfhi(x.x), bflo(x.y), bfhi(x.y)}; b1 = (f32x4){bflo(x.z), bfhi(x.z), bflo(x.w), bfhi(x.w)}; }
                    const f32x4 r0 = b0 + gv[bj][0] * acc[ai][bj][m][0], r1 = b1 + gv[bj][1] * acc[ai][bj][m][1];
                    u32x4 o; o.x = cvt_pk_bf16(r0[0], r0[1]); o.y = cvt_pk_bf16(r0[2], r0[3]); o.z = cvt_pk_bf16(r1[0], r1[1]); o.w = cvt_pk_bf16(r1[2], r1[3]);
                    *(u32x4*)(xb + off + bj * HALF) = o; } }
    }
};
struct EpiSwiglu {
    static constexpr bool PERM = true;
    bf16* Hh; int ldc;
    __device__ __forceinline__ void operator()(const f32x4 (&acc)[2][2][4][2], const Unit& u, int wr, int wc, int fr, int fq) const {
        const int row0 = u.pm * BM + wr * 64 + fr, col0 = u.pn * HALF + wc * 32 + 8 * fq;
#pragma unroll
        for (int ai = 0; ai < 2; ++ai)
#pragma unroll
            for (int m = 0; m < 4; ++m) { bf16* rowp = Hh + (size_t)(row0 + ai * HALF + m * 16) * ldc + col0;
                const f32x4 g0 = acc[ai][0][m][0], g1 = acc[ai][0][m][1], u0 = acc[ai][1][m][0], u1 = acc[ai][1][m][1];
                u32x4 w; w.x = cvt_pk_bf16(silu_f(g0[0]) * u0[0], silu_f(g0[1]) * u0[1]); w.y = cvt_pk_bf16(silu_f(g0[2]) * u0[2], silu_f(g0[3]) * u0[3]);
                w.z = cvt_pk_bf16(silu_f(g1[0]) * u1[0], silu_f(g1[1]) * u1[1]); w.w = cvt_pk_bf16(silu_f(g1[2]) * u1[2], silu_f(g1[3]) * u1[3]);
                *(u32x4*)rowp = w; }
    }
};
struct EpiBf16 {
    static constexpr bool PERM = true;
    bf16* O; int ldc; float sc;
    __device__ __forceinline__ void operator()(const f32x4 (&acc)[2][2][4][2], const Unit& u, int wr, int wc, int fr, int fq) const {
        const int row0 = u.pm * BM + wr * 64 + fr, col0 = u.pn * BM + wc * 32 + 8 * fq;
#pragma unroll
        for (int ai = 0; ai < 2; ++ai)
#pragma unroll
            for (int m = 0; m < 4; ++m) { bf16* rowp = O + (size_t)(row0 + ai * HALF + m * 16) * ldc + col0;
#pragma unroll
                for (int bj = 0; bj < 2; ++bj) { const f32x4 v0 = acc[ai][bj][m][0] * sc, v1 = acc[ai][bj][m][1] * sc;
                    u32x4 w; w.x = cvt_pk_bf16(v0[0], v0[1]); w.y = cvt_pk_bf16(v0[2], v0[3]); w.z = cvt_pk_bf16(v1[0], v1[1]); w.w = cvt_pk_bf16(v1[2], v1[3]);
                    *(u32x4*)(rowp + bj * HALF) = w; } }
    }
};
struct EpiSwiglu8 {
    static constexpr bool PERM = true;
    unsigned char* Hh; int ldc; float isc, osc;
    __device__ __forceinline__ void operator()(const f32x4 (&acc)[2][2][4][2], const Unit& u, int wr, int wc, int fr, int fq) const {
        const int row0 = u.pm * BM + wr * 64 + fr, col0 = u.pn * HALF + wc * 32 + 8 * fq;
#pragma unroll
        for (int ai = 0; ai < 2; ++ai)
#pragma unroll
            for (int m = 0; m < 4; ++m) { unsigned char* rowp = Hh + (size_t)(row0 + ai * HALF + m * 16) * ldc + col0;
                const f32x4 g0 = acc[ai][0][m][0] * isc, g1 = acc[ai][0][m][1] * isc, u0 = acc[ai][1][m][0] * (isc * osc), u1 = acc[ai][1][m][1] * (isc * osc);
                u32x2 w; w.x = pk4_fp8(silu_f(g0[0]) * u0[0], silu_f(g0[1]) * u0[1], silu_f(g0[2]) * u0[2], silu_f(g0[3]) * u0[3]);
                w.y = pk4_fp8(silu_f(g1[0]) * u1[0], silu_f(g1[1]) * u1[1], silu_f(g1[2]) * u1[2], silu_f(g1[3]) * u1[3]);
                *(u32x2*)rowp = w; }
    }
};
struct EpiPart {
    static constexpr bool PERM = false;
    float* P; int row_base, nrows, kbytes; float sc;
    __device__ __forceinline__ void operator()(const f32x4 (&acc)[2][2][4][2], const Unit& u, int wr, int wc, int fr, int fq) const {
        const int row0 = u.pm * BM - row_base + wr * 64 + fr, col0 = u.pn * BM + wc * 32 + 4 * fq; float* base = P + (size_t)(u.koff / kbytes) * nrows * D;
#pragma unroll
        for (int ai = 0; ai < 2; ++ai)
#pragma unroll
            for (int m = 0; m < 4; ++m) { float* rowp = base + (size_t)(row0 + ai * HALF + m * 16) * D + col0;
#pragma unroll
                for (int bj = 0; bj < 2; ++bj)
#pragma unroll
                    for (int n = 0; n < 2; ++n) *(f32x4*)(rowp + bj * HALF + n * 16) = acc[ai][bj][m][n] * sc; }
    }
};
struct EpiQKV {
    static constexpr bool PERM = true;
    bf16* Q; bf16* Kb; bf16* Vb; const float* qg; const float* kg; const float* cs;
    __device__ __forceinline__ void operator()(const f32x4 (&acc)[2][2][4][2], const Unit& u, int wr, int wc, int fr, int fq) const {
        const int row0 = u.pm * BM + wr * 64 + fr; const int t = u.pn;
        bf16* base; int ld; const float* gn; float osc;
        if (t < 8) { base = Q + (size_t)(4 * t + wc) * HD; ld = D; gn = qg; osc = 0.125f; } else if (t == 8) { base = Kb + wc * HD; ld = 4 * HD; gn = kg; osc = 1.f; } else { base = Vb + wc * HD; ld = 4 * HD; gn = kg; osc = 1.f; }
        f32x4 gv[2][2];
#pragma unroll
        for (int bj = 0; bj < 2; ++bj)
#pragma unroll
            for (int n = 0; n < 2; ++n) gv[bj][n] = *(const f32x4*)(gn + 32 * bj + 8 * fq + 4 * n);
#pragma unroll
        for (int ai = 0; ai < 2; ++ai)
#pragma unroll
            for (int m = 0; m < 4; ++m) { const int row = row0 + ai * HALF + m * 16; bf16* rowp = base + (size_t)row * ld + 8 * fq;
                f32x4 v[2][2];
#pragma unroll
                for (int bj = 0; bj < 2; ++bj)
#pragma unroll
                    for (int n = 0; n < 2; ++n) v[bj][n] = acc[ai][bj][m][n];
                if (t < 9) {
                    float ss = 0.f;
#pragma unroll
                    for (int bj = 0; bj < 2; ++bj)
#pragma unroll
                        for (int n = 0; n < 2; ++n) ss += (v[bj][n][0] * v[bj][n][0] + v[bj][n][1] * v[bj][n][1]) + (v[bj][n][2] * v[bj][n][2] + v[bj][n][3] * v[bj][n][3]);
                    ss += __shfl_xor(ss, 16); ss += __shfl_xor(ss, 32);
                    const float r = __builtin_amdgcn_rsqf(ss * (1.0f / HD) + EPS);
#pragma unroll
                    for (int bj = 0; bj < 2; ++bj)
#pragma unroll
                        for (int n = 0; n < 2; ++n) v[bj][n] = v[bj][n] * r * gv[bj][n];
                    const float* csr = cs + (size_t)row * 16;
#pragma unroll
                    for (int n = 0; n < 2; ++n) { f32x4 cv = (f32x4){1.f, 1.f, 1.f, 1.f}, sv = (f32x4){0.f, 0.f, 0.f, 0.f};
                        if (fq < 2) { cv = *(const f32x4*)(csr + 4 * n); sv = *(const f32x4*)(csr + 8 + 4 * n); }
                        f32x4 o;
#pragma unroll
                        for (int j = 0; j < 4; ++j) o[j] = __shfl_xor(v[0][n][j], 16);
                        if (fq == 0) v[0][n] = v[0][n] * cv - o * sv; else if (fq == 1) v[0][n] = v[0][n] * cv + o * sv; }
                }
#pragma unroll
                for (int bj = 0; bj < 2; ++bj) { const f32x4 v0 = v[bj][0] * osc, v1 = v[bj][1] * osc;
                    u32x4 w; w.x = cvt_pk_bf16(v0[0], v0[1]); w.y = cvt_pk_bf16(v0[2], v0[3]); w.z = cvt_pk_bf16(v1[0], v1[1]); w.w = cvt_pk_bf16(v1[2], v1[3]);
                    *(u32x4*)(rowp + 32 * bj) = w; } }
    }
};

#ifndef PG8_ALIGN
#define PG8_ALIGN true
#endif
template <class Epi, bool F8 = false, bool ALIGN_EPI = PG8_ALIGN, bool GATH = false>
__device__ __forceinline__ void gemm_phase(LAS unsigned char* lds, const Gemm g, const Order& S, const Epi& E) {
    const int tid = threadIdx.x, wid = __builtin_amdgcn_readfirstlane(tid >> 6), lane = tid & 63, wr = wid >> 2, wc = wid & 3, fr = lane & 15, fq = lane >> 4;
    const int RB = g.rowbytes, nt = g.ktiles ? g.ktiles : RB / 128;
    unsigned voffA[2], voffB[2];
#pragma unroll
    for (int i = 0; i < 2; ++i) { int R, C; stage_rc(tid * 16 + i * 8192, R, C); const int Rb = Epi::PERM ? ((R & ~31) + perm32(R & 31)) : R;
        voffA[i] = (unsigned)(R * RB + C * 2); voffB[i] = (unsigned)(Rb * RB + C * 2); }
    unsigned gA[2], gN[2]; int gR0; unsigned gCb; { int R_, C_; stage_rc(tid * 16, R_, C_); gR0 = R_; gCb = (unsigned)(C_ * 2); }
    const size_t kstep = (size_t)(BK * 2);
    const size_t hstep = (size_t)HALF * RB;
    const size_t tstep = 2 * hstep;
    const unsigned ldsw = (unsigned)wid * 1024u;
    const int aoff = lds_byte(wr * 64 + fr, fq * 8), boff = lds_byte(wc * 32 + fr, fq * 8);
#define PG8_SA(b, h) (((b) * 2 + (h)) * HTB)
#define PG8_SB(b, h) ((4 + (b) * 2 + (h)) * HTB)
#define PG8_STAGE(bufoff, gbase, voff) do { _Pragma("unroll") for (int _i = 0; _i < 2; ++_i) \
        __builtin_amdgcn_global_load_lds((const unsigned*)((const char*)(gbase) + (voff)[_i]), (LAS unsigned*)(lds + (bufoff) + ldsw + _i * 8192), 16, 0, 0); } while (0)
#define PG8_STAGE_A(bufoff, gbase, h_, nx_) do { _Pragma("unroll") for (int _i = 0; _i < 2; ++_i) { \
        const unsigned o_ = GATH ? ((((nx_) ? gN[h_] : gA[h_]) >> (16 * _i)) & 0xffffu) * (unsigned)RB + gCb : voffA[_i]; const char* b_ = GATH ? (const char*)(gbase) : (const char*)(gbase) + ((h_) ? hstep : 0); \
        __builtin_amdgcn_global_load_lds((const unsigned*)(b_ + o_), (LAS unsigned*)(lds + (bufoff) + ldsw + _i * 8192), 16, 0, 0); } } while (0)
#define PG8_GLOAD(dst_, pm_) do { _Pragma("unroll") for (int h_ = 0; h_ < 2; ++h_) dst_[h_] = g.rowoff[(pm_) * BM + h_ * HALF + gR0] | (g.rowoff[(pm_) * BM + h_ * HALF + gR0 + 64] << 16); } while (0)
#define PG8_RD(off) (*(const LAS bf16x8*)(lds + (off)))
#define PG8_LDA(dst, b, h) do { _Pragma("unroll") for (int m = 0; m < 4; ++m) { if constexpr (F8) dst##8[m] = PG8_CAT(PG8_RD(PG8_SA(b, h) + aoff + m * 2048), PG8_RD(PG8_SA(b, h) + aoff + m * 2048 + 1024)); \
        else { dst[m][0] = PG8_RD(PG8_SA(b, h) + aoff + m * 2048); dst[m][1] = PG8_RD(PG8_SA(b, h) + aoff + m * 2048 + 1024); } } } while (0)
#define PG8_LDB(dst, b, h) do { _Pragma("unroll") for (int n = 0; n < 2; ++n) { if constexpr (F8) dst##8[n] = PG8_CAT(PG8_RD(PG8_SB(b, h) + boff + n * 2048), PG8_RD(PG8_SB(b, h) + boff + n * 2048 + 1024)); \
        else { dst[n][0] = PG8_RD(PG8_SB(b, h) + boff + n * 2048); dst[n][1] = PG8_RD(PG8_SB(b, h) + boff + n * 2048 + 1024); } } } while (0)
#define PG8_MMA(ai, bj, At, Bt) do { __builtin_amdgcn_s_setprio(1); _Pragma("unroll") for (int m = 0; m < 4; ++m) _Pragma("unroll") for (int n = 0; n < 2; ++n) { \
        if constexpr (F8) { asm volatile("v_mfma_f32_16x16x128_f8f6f4 %0, %1, %2, %0" : "+v"(acc[ai][bj][m][n]) : "v"(Bt##8[n]), "v"(At##8[m])); } \
        else { _Pragma("unroll") for (int k = 0; k < 2; ++k) acc[ai][bj][m][n] = __builtin_amdgcn_mfma_f32_16x16x32_bf16(Bt[n][k], At[m][k], acc[ai][bj][m][n], 0, 0, 0); } } \
        __builtin_amdgcn_s_setprio(0); } while (0)
#define PG8_CAT(x, y) __builtin_shufflevector(__builtin_bit_cast(i32x4, x), __builtin_bit_cast(i32x4, y), 0, 1, 2, 3, 4, 5, 6, 7)
#define PG8_WAIT_V(n) asm volatile("s_waitcnt vmcnt(" #n ")" ::: "memory")
#define PG8_WAIT_L(n) asm volatile("s_waitcnt lgkmcnt(" #n ")" ::: "memory")
#define PG8_BAR __builtin_amdgcn_s_barrier()
#define PG8_SCHED __builtin_amdgcn_sched_barrier(0)
    Unit cur, nxt; int ui = 0;
    if (!S.next(0, cur)) return;
    f32x4 acc[2][2][4][2];
#pragma unroll
    for (int a = 0; a < 2; ++a)
#pragma unroll
        for (int b = 0; b < 2; ++b)
#pragma unroll
            for (int m = 0; m < 4; ++m)
#pragma unroll
                for (int n = 0; n < 2; ++n) acc[a][b][m][n] = (f32x4){0.f, 0.f, 0.f, 0.f};
    bf16x8 At[4][2], B0[2][2], B1[2][2]; i32x8 At8[4], B08[2], B18[2];
    const char* cA = (const char*)g.A + (GATH ? (size_t)0 : (size_t)cur.pm * tstep) + cur.koff;
    if constexpr (GATH) PG8_GLOAD(gA, cur.pm); const char* cB = (const char*)g.Bt + (size_t)cur.eb * g.bstride + (size_t)cur.pn * tstep + cur.koff;
    PG8_STAGE(PG8_SB(0, 0), cB, voffB); PG8_STAGE(PG8_SB(0, 1), cB + hstep, voffB); PG8_STAGE_A(PG8_SA(0, 0), cA, 0, false); PG8_STAGE_A(PG8_SA(0, 1), cA, 1, false);
    if (wr == 1) PG8_BAR;
    PG8_WAIT_V(2); PG8_BAR;
    PG8_STAGE(PG8_SB(1, 0), cB + kstep, voffB); PG8_STAGE_A(PG8_SA(1, 0), cA + kstep, 0, false); PG8_STAGE(PG8_SB(1, 1), cB + hstep + kstep, voffB);
    PG8_WAIT_V(6); PG8_BAR;
    for (;;) {
        const bool has_next = S.next(ui + 1, nxt);
        const char* nA = has_next ? (const char*)g.A + (GATH ? (size_t)0 : (size_t)nxt.pm * tstep) + nxt.koff : cA;
        if constexpr (GATH) { if (has_next) PG8_GLOAD(gN, nxt.pm); } const char* nB = has_next ? (const char*)g.Bt + (size_t)nxt.eb * g.bstride + (size_t)nxt.pn * tstep + nxt.koff : cB;
        for (int t = 0; t < nt; t += 2) {
            const bool last = (t == nt - 2); const bool nx = last && has_next;
            const char* a1 = cA + (size_t)(t + 1) * kstep;
            const char* a2 = last ? nA : cA + (size_t)(t + 2) * kstep; const char* b2 = last ? nB : cB + (size_t)(t + 2) * kstep;
            const char* a3 = a2 + kstep; const char* b3 = b2 + kstep;
            PG8_LDB(B0, 0, 0); PG8_LDB(B1, 0, 1); PG8_SCHED; PG8_LDA(At, 0, 0); PG8_STAGE_A(PG8_SA(1, 1), a1, 1, false);
            PG8_WAIT_V(8); PG8_WAIT_L(0); PG8_BAR; PG8_MMA(0, 0, At, B0); PG8_MMA(0, 1, At, B1); PG8_BAR; PG8_SCHED;
            PG8_LDA(At, 0, 1); PG8_STAGE(PG8_SB(0, 0), b2, voffB); PG8_STAGE(PG8_SB(0, 1), b2 + hstep, voffB); PG8_STAGE_A(PG8_SA(0, 0), a2, 0, nx);
            PG8_WAIT_V(8); PG8_WAIT_L(0); PG8_BAR; PG8_MMA(1, 0, At, B0); PG8_MMA(1, 1, At, B1); PG8_BAR; PG8_SCHED;
            PG8_LDB(B0, 1, 0); PG8_LDB(B1, 1, 1); PG8_SCHED; PG8_LDA(At, 1, 0); PG8_STAGE_A(PG8_SA(0, 1), a2, 1, nx);
            PG8_WAIT_V(8); PG8_WAIT_L(0); PG8_BAR; PG8_MMA(0, 0, At, B0); PG8_MMA(0, 1, At, B1); PG8_BAR; PG8_SCHED;
            PG8_LDA(At, 1, 1); PG8_STAGE(PG8_SB(1, 0), b3, voffB); PG8_STAGE(PG8_SB(1, 1), b3 + hstep, voffB); PG8_STAGE_A(PG8_SA(1, 0), a3, 0, nx);
            PG8_WAIT_V(8); PG8_WAIT_L(0); PG8_BAR; PG8_MMA(1, 0, At, B0); PG8_MMA(1, 1, At, B1); PG8_BAR; PG8_SCHED;
        }
        if constexpr (F8) asm volatile("s_nop 15\n\ts_nop 15" ::: "memory");
        if constexpr (ALIGN_EPI) { if (wr == 0) PG8_BAR; }
        E(acc, cur, wr, wc, fr, fq);
        if (!has_next) break;
#pragma unroll
        for (int a = 0; a < 2; ++a)
#pragma unroll
            for (int b = 0; b < 2; ++b)
#pragma unroll
                for (int m = 0; m < 4; ++m)
#pragma unroll
                    for (int n = 0; n < 2; ++n) acc[a][b][m][n] = (f32x4){0.f, 0.f, 0.f, 0.f};
        cur = nxt; cA = nA; cB = nB; ++ui;
        if constexpr (GATH) { gA[0] = gN[0]; gA[1] = gN[1]; }
        if constexpr (ALIGN_EPI) { if (wr == 1) PG8_BAR; }
    }
    PG8_WAIT_V(0);
    if constexpr (!ALIGN_EPI) { if (wr == 0) PG8_BAR; }
    PG8_BAR;
#undef PG8_SA
#undef PG8_SB
#undef PG8_STAGE
#undef PG8_STAGE_A
#undef PG8_GLOAD
#undef PG8_LDA
#undef PG8_RD
#undef PG8_LDB
#undef PG8_MMA
#undef PG8_CAT
#undef PG8_WAIT_V
#undef PG8_WAIT_L
#undef PG8_BAR
#undef PG8_SCHED
}
}

struct Frame {
    LAS unsigned char* lds;
    volatile LAS unsigned* MISC;
    unsigned* ctl;
    int tid, lane, wave, G, bid;
    const float* in[24]; float* out; unsigned char* ws;
};
#define WSP(T, off) ((T*)(F.ws + (off)))

__device__ __forceinline__ int dest_row(int mode, int ffn, int n0) {
    if (mode == 0) return n0;
    if (mode == 1) { const int up = n0 >= ffn ? 1 : 0, j = n0 - up * ffn; return (j >> 7) * 256 + up * 128 + (j & 127); }
    const int tile = n0 >> 8, hh = (n0 & 255) >> 6, d = n0 & 63; return tile * 256 + (d >> 5) * 128 + hh * 32 + (d & 31);
}
constexpr int CV_I_IN = (D / 64) * (NIN / 32), CV_I_OUT = (GW / 64) * (D / 32), CV_I_GU = (D / 64) * (2 * FF / 32), CV_I_DN = (FF / 64) * (D / 32), CV_I_QKV = (D / 64) * (NQKV / 32), CV_I_O = (D / 64) * (D / 32);
constexpr int CV_I_MGU = (D / 64) * (2 * FFE / 32), CV_I_MDN = (FFE / 64) * (D / 32);
constexpr int CV_DENSE = CV_I_IN + CV_I_OUT + CV_I_GU + CV_I_DN + CV_I_QKV + CV_I_O, CV_NITEMS = CV_DENSE + NE * (CV_I_MGU + CV_I_MDN);
constexpr int CV_P0_END = CV_I_IN;
constexpr int CV_HID = CV_NITEMS - CV_P0_END;
constexpr int CV_B0 = CV_P0_END, CV_B1 = CV_B0 + (int)((long)CV_HID * 330 / 1000), CV_B2 = CV_B1 + (int)((long)CV_HID * 60 / 1000), CV_B3 = CV_B2 + (int)((long)CV_HID * 400 / 1000),
              CV_B4 = CV_B3 + (int)((long)CV_HID * 80 / 1000), CV_B5 = CV_B4 + (int)((long)CV_HID * 90 / 1000), CV_B6 = CV_NITEMS;
static_assert(CV_B1 >= CV_DENSE, "all dense-layer weights are converted by the end of P2");
__device__ __forceinline__ void convert_items(Frame& F, int first, int last, int gw, int NGW) {
    const int lane = F.lane, w = F.wave;
        LAS float* scr = (LAS float*)(F.lds + w * 16384);
        struct ItemD { const float* src; unsigned char* dst; int N, K, f8; };
        auto decode = [&](int it) -> ItemD {
            int r = it; const float* W; unsigned char* WT; int K, N, mode = 0, ffn = 0, f8 = 0;
            if (r < CV_I_IN) { W = F.in[6]; K = D; N = NIN; WT = F.ws + WS_WIN; }
            else if ((r -= CV_I_IN) < CV_I_OUT) { W = F.in[12]; K = GW; N = D; WT = F.ws + WS_WOUT; f8 = 1; }
            else if ((r -= CV_I_OUT) < CV_I_GU) { W = F.in[18]; K = D; N = 2 * FF; WT = F.ws + WS_WGU; mode = 1; ffn = FF; }
            else if ((r -= CV_I_GU) < CV_I_DN) { W = F.in[19]; K = FF; N = D; WT = F.ws + WS_WD; f8 = 1; }
            else if ((r -= CV_I_DN) < CV_I_QKV) { W = F.in[13]; K = D; N = NQKV; WT = F.ws + WS_WQKV; mode = 2; }
            else if ((r -= CV_I_QKV) < CV_I_O) { W = F.in[17]; K = D; N = D; WT = F.ws + WS_WO; }
            else if ((r -= CV_I_O) < NE * CV_I_MGU) { const int e = r / CV_I_MGU; r -= e * CV_I_MGU; W = F.in[22] + (size_t)e * D * 2 * FFE; K = D; N = 2 * FFE; WT = F.ws + WS_MWGU + (size_t)e * 2 * FFE * D; mode = 1; ffn = FFE; f8 = 1; }
            else { r -= NE * CV_I_MGU; const int e = r / CV_I_MDN; r -= e * CV_I_MDN; W = F.in[23] + (size_t)e * FFE * D; K = FFE; N = D; WT = F.ws + WS_MWD + (size_t)e * D * FFE; f8 = 1; }
            const int nblk = N / 32, kb = r / nblk, nb = r - kb * nblk, k0 = 64 * kb, n0 = 32 * nb;
            ItemD d; d.src = W + (size_t)k0 * N + n0; d.dst = WT + ((size_t)dest_row(mode, ffn, n0) * K + k0) * (f8 ? 1 : 2); d.N = N; d.K = K; d.f8 = f8; return d;
        };
        constexpr int PT = 36;
        f32x4 vc[8], vn[8];
        ItemD dc, dn; dn.src = nullptr; dn.dst = nullptr; dn.N = 0; dn.K = 0; dn.f8 = 0; dc = dn;
#define CV_LOAD(v_, d_) do { const float* p_ = (d_).src + (size_t)(lane >> 3) * (d_).N + 4 * (lane & 7); _Pragma("unroll") for (int i = 0; i < 8; ++i) v_[i] = __builtin_nontemporal_load((const f32x4*)(p_ + (size_t)(8 * i) * (d_).N)); } while (0)
        int it = first + gw;
        if (it < last) { dc = decode(it); CV_LOAD(vc, dc); }
        for (; it < last; it += NGW) {
            const bool has = it + NGW < last;
            if (has) { dn = decode(it + NGW); CV_LOAD(vn, dn); }
            const float scl = dc.f8 ? SC_W : 1.0f;
            if (dc.f8) {
#pragma unroll
                for (int i = 0; i < 8; ++i) *(LAS f32x4*)(scr + (8 * i + (lane >> 3)) * PT + 4 * (lane & 7)) = vc[i] * scl;
            } else {
#pragma unroll
                for (int i = 0; i < 8; ++i) { LAS float* q = scr + (8 * i + (lane >> 3)) * 33 + 4 * (lane & 7); q[0] = vc[i][0]; q[1] = vc[i][1]; q[2] = vc[i][2]; q[3] = vc[i][3]; }
            }
            LDS_WAIT(); asm volatile("" ::: "memory");
            if (dc.f8) {
                const int n = lane >> 1, kc = lane & 1; const LAS float* sp = scr + (32 * kc) * PT + n;
                u32x4 o0, o1;
                o0.x = pk4_fp8(sp[0 * PT], sp[1 * PT], sp[2 * PT], sp[3 * PT]); o0.y = pk4_fp8(sp[4 * PT], sp[5 * PT], sp[6 * PT], sp[7 * PT]);
                o0.z = pk4_fp8(sp[8 * PT], sp[9 * PT], sp[10 * PT], sp[11 * PT]); o0.w = pk4_fp8(sp[12 * PT], sp[13 * PT], sp[14 * PT], sp[15 * PT]);
                o1.x = pk4_fp8(sp[16 * PT], sp[17 * PT], sp[18 * PT], sp[19 * PT]); o1.y = pk4_fp8(sp[20 * PT], sp[21 * PT], sp[22 * PT], sp[23 * PT]);
                o1.z = pk4_fp8(sp[24 * PT], sp[25 * PT], sp[26 * PT], sp[27 * PT]); o1.w = pk4_fp8(sp[28 * PT], sp[29 * PT], sp[30 * PT], sp[31 * PT]);
                unsigned char* dp = dc.dst + (size_t)n * dc.K + 32 * kc;
                __builtin_nontemporal_store(o0, (u32x4*)dp); __builtin_nontemporal_store(o1, (u32x4*)(dp + 16));
            } else {
                const int c = lane & 7;
#pragma unroll
                for (int j = 0; j < 4; ++j) { const int n = (lane >> 3) + 8 * j; const LAS float* sp = scr + (8 * c) * 33 + n;
                    u32x4 o; o.x = pk2(sp[0 * 33], sp[1 * 33]); o.y = pk2(sp[2 * 33], sp[3 * 33]); o.z = pk2(sp[4 * 33], sp[5 * 33]); o.w = pk2(sp[6 * 33], sp[7 * 33]);
                    *(u32x4*)(dc.dst + ((size_t)n * dc.K + 8 * c) * 2) = o; }
            }
            LDS_WAIT(); asm volatile("" ::: "memory");
            if (has) { dc = dn;
#pragma unroll
                for (int i = 0; i < 8; ++i) vc[i] = vn[i]; }
        }
#undef CV_LOAD
}

__device__ __forceinline__ void p0_prologue(Frame& F) {
    const int tid = F.tid, lane = F.lane, w = F.wave;
    {
        LAS float* sc = (LAS float*)F.lds;
        LAS float* red = (LAS float*)(F.lds + 32768);
        const float* c = F.in[1];
        for (int i = tid; i < NB * D; i += NTHR) { const float x = c[i]; sc[i] = x / (1.0f + __expf(-x)); }
        __syncthreads();
        for (int vb = F.bid; vb < 256; vb += F.G) {
            const int colg = vb * 96, l = colg / (6 * D), j0 = colg % (6 * D);
            const float* Wl = F.in[3] + (size_t)l * D * (6 * D) + j0;
            const int rr = lane / 24, cc = lane % 24; const bool act = lane < 48;
            f32x4 a[4]; for (int b = 0; b < 4; ++b) a[b] = (f32x4){0.f, 0.f, 0.f, 0.f};
            if (act) {
                for (int i0 = 0; i0 < 128; i0 += 8) {
                    f32x4 wv[8];
#pragma unroll
                    for (int i = 0; i < 8; ++i) { const int k = 16 * (i0 + i) + 2 * w + rr; wv[i] = *(const f32x4*)(Wl + (size_t)k * (6 * D) + 4 * cc); }
#pragma unroll
                    for (int i = 0; i < 8; ++i) { const int k = 16 * (i0 + i) + 2 * w + rr;
#pragma unroll
                        for (int b = 0; b < 4; ++b) a[b] += wv[i] * sc[b * D + k]; }
                }
#pragma unroll
                for (int b = 0; b < 4; ++b)
#pragma unroll
                    for (int j = 0; j < 4; ++j) red[((2 * w + rr) * 4 + b) * 96 + 4 * cc + j] = a[b][j];
            }
            __syncthreads();
            if (tid < 384) { const int b = tid / 96, col = tid % 96; float s = 0.f;
#pragma unroll
                for (int p = 0; p < 16; ++p) s += red[(p * 4 + b) * 96 + col];
                WSP(float, WS_MOD)[(size_t)(l * NB + b) * (6 * D) + j0 + col] = s + F.in[4][(size_t)l * (6 * D) + j0 + col]; }
            __syncthreads();
        }
    }
    {
        const int* pos = (const int*)F.in[2];
        for (int idx = F.bid * NTHR + tid; idx < M * 8; idx += F.G * NTHR) { const int row = idx >> 3, i = idx & 7;
            const float invf = powf(500000.0f, -(float)(2 * i) / 16.0f); const float ang = (float)pos[row] * invf;
            double t = (double)ang * 0.15915494309189535; t -= __builtin_rint(t);
            const float tf = (float)t;
            WSP(float, WS_CS)[(size_t)row * 16 + i] = __builtin_amdgcn_cosf(tf); WSP(float, WS_CS)[(size_t)row * 16 + 8 + i] = __builtin_amdgcn_sinf(tf); }
    }
    {
        const float* wsp = F.in[10]; bf16* o = WSP(bf16, WS_WSB);
        for (int idx = F.bid * NTHR + tid; idx < 8 * 128 * 128; idx += F.G * NTHR) { const int s = idx & 127, t = (idx >> 7) & 127; o[idx] = (s <= t) ? (bf16)f2bf(wsp[idx]) : (bf16)0; }
    }
    convert_items(F, 0, CV_P0_END, F.bid * NWAVES + F.wave, F.G * NWAVES);
}

template <bool ROUTER, bool SRC16 = false>
__device__ __forceinline__ void norm_phase(Frame& F, const float* src, int l, int which) {
    const int tid = F.tid, lane = F.lane, w = F.wave;
    LAS float* TA = (LAS float*)F.lds;
    LAS float* TS = (LAS float*)(F.lds + 8192);
    LAS float* RW = (LAS float*)(F.lds + 16384);
    volatile LAS int* hist = (volatile LAS int*)(F.lds + 16384 + 65536);
    const float* ng = F.in[5] + (size_t)(l * 2 + which) * D;
    if (ROUTER) { const float* rw = F.in[20]; for (int i = tid; i < D * NE; i += NTHR) { const int c = i >> 3, e = i & 7; RW[e * D + c] = rw[i]; } }
    for (int vb = F.bid; vb < 256; vb += F.G) {
        const int b = vb / 64; const float* mod = WSP(float, WS_MOD) + (size_t)(l * NB + b) * (6 * D);
        __syncthreads();
        for (int i = tid; i < D; i += NTHR) { TA[i] = ng[i] * (1.0f + mod[(which ? 4 : 1) * D + i]); TS[i] = mod[(which ? 3 : 0) * D + i]; }
        if (ROUTER && tid < 8) hist[tid] = 0;
        __syncthreads();
        f32x4 vnx[8]; u32x2 vnh[8];
        if constexpr (SRC16) { const u32x2* xr = (const u32x2*)((const bf16*)src + (size_t)(vb * 64 + w * 8) * D) + lane;
#pragma unroll
          for (int j = 0; j < 8; ++j) vnh[j] = xr[64 * j]; }
        else { const f32x4* xr = (const f32x4*)(src + (size_t)(vb * 64 + w * 8) * D) + lane;
#pragma unroll
          for (int j = 0; j < 8; ++j) vnx[j] = xr[64 * j]; }
        for (int i = 0; i < 8; ++i) {
            const int row = vb * 64 + w * 8 + i;
            f32x4 v[8]; float ss = 0.f;
#pragma unroll
            for (int j = 0; j < 8; ++j) { if constexpr (SRC16) v[j] = (f32x4){bflo(vnh[j].x), bfhi(vnh[j].x), bflo(vnh[j].y), bfhi(vnh[j].y)}; else v[j] = vnx[j]; }
            if (i < 7) {
                if constexpr (SRC16) { const u32x2* xr = (const u32x2*)((const bf16*)src + (size_t)(row + 1) * D) + lane;
#pragma unroll
                    for (int j = 0; j < 8; ++j) vnh[j] = xr[64 * j]; }
                else { const f32x4* xr = (const f32x4*)(src + (size_t)(row + 1) * D) + lane;
#pragma unroll
                    for (int j = 0; j < 8; ++j) vnx[j] = xr[64 * j]; } }
#pragma unroll
            for (int j = 0; j < 8; ++j) ss += (v[j][0] * v[j][0] + v[j][1] * v[j][1]) + (v[j][2] * v[j][2] + v[j][3] * v[j][3]);
            const float rstd = __builtin_amdgcn_rsqf(wave_sum(ss) * (1.0f / D) + EPS);
            u32x2* o8 = (u32x2*)(WSP(bf16, WS_H) + (size_t)row * D) + lane;
#pragma unroll
            for (int j = 0; j < 8; ++j) { const f32x4 a = *(const LAS f32x4*)(TA + 256 * j + 4 * lane), s = *(const LAS f32x4*)(TS + 256 * j + 4 * lane);
                v[j] = v[j] * rstd * a + s;
                if (ROUTER) ((unsigned*)(WSP(unsigned char, WS_H) + (size_t)row * D) + lane)[64 * j] = pk4_fp8(v[j][0] * SC_H, v[j][1] * SC_H, v[j][2] * SC_H, v[j][3] * SC_H);
                else o8[64 * j] = (u32x2){pk2(v[j][0], v[j][1]), pk2(v[j][2], v[j][3])}; }
            if (ROUTER) {
                float lg[8];
#pragma unroll
                for (int e = 0; e < 8; ++e) { float a = 0.f;
#pragma unroll
                    for (int j = 0; j < 8; ++j) { const f32x4 r = *(const LAS f32x4*)(RW + e * D + 256 * j + 4 * lane); a += (v[j][0] * r[0] + v[j][1] * r[1]) + (v[j][2] * r[2] + v[j][3] * r[3]); }
                    lg[e] = wave_sum(a) + F.in[21][e]; }
                int e1 = 0; float l1 = lg[0];
#pragma unroll
                for (int e = 1; e < 8; ++e) if (lg[e] > l1) { l1 = lg[e]; e1 = e; }
                int e2 = -1; float l2 = -3.0e38f;
#pragma unroll
                for (int e = 0; e < 8; ++e) if (e != e1 && lg[e] > l2) { l2 = lg[e]; e2 = e; }
                const float ex = __expf(l2 - l1), w1 = 1.0f / (1.0f + ex), w2 = ex * w1;
                if (lane == 0) { WSP(int, WS_TOKE)[row] = e1 | (e2 << 8); WSP(f32x2, WS_TOKW)[row] = (f32x2){w1, w2}; atomicAdd((int*)&hist[e1], 1); atomicAdd((int*)&hist[e2], 1); }
            }
        }
        if (ROUTER) { __syncthreads(); if (tid < 8) ((int*)F.ctl)[CW_CNT + vb * 8 + tid] = hist[tid]; }
    }
}

constexpr float SC_U = 8.0f;
__device__ __forceinline__ void gate_phase(Frame& F, bf16* Uo, unsigned char* U8 = nullptr) {
    const int tid = F.tid, lane = F.lane, w = F.wave, i16 = lane & 15, quad = lane >> 4;
    constexpr int PITCH = 528;
    LAS unsigned char* VN = F.lds;
    LAS f32x2* ST = (LAS f32x2*)(F.lds + 128 * PITCH);
    const bf16* Vv = WSP(bf16, WS_V); const bf16* Uu = WSP(bf16, WS_U);
    const int cg = tid & 31, rb = tid >> 5;
    u32x4 vreg[8], ureg[8]; f32x4 lg0, lg1, lb0, lb1;
#define GATE_STATS(u_, buf_) do { const int row0_ = ((u_) >> 3) * 128; const int row_ = tid >> 2, part_ = tid & 3; const f32x4* p_ = (const f32x4*)(WSP(f32x2, WS_VST) + (size_t)(row0_ + row_) * 64 + part_ * 16); \
        float s_ = 0.f, q_ = 0.f; _Pragma("unroll") for (int i_ = 0; i_ < 8; ++i_) { const f32x4 x_ = p_[i_]; s_ += x_[0] + x_[2]; q_ += x_[1] + x_[3]; } \
        s_ += __shfl_xor(s_, 1); s_ += __shfl_xor(s_, 2); q_ += __shfl_xor(q_, 1); q_ += __shfl_xor(q_, 2); \
        const float mean_ = s_ * (1.0f / GW), var_ = q_ * (1.0f / GW) - mean_ * mean_; \
        if (part_ == 0) ST[(buf_) * 128 + row_] = (f32x2){mean_, __builtin_amdgcn_rsqf(fmaxf(var_, 0.f) + EPS)}; } while (0)
#define GATE_LOAD(ci_) do { const int u_ = F.bid + F.G * ((ci_) >> 1); if (u_ < 1024) { const int row0_ = (u_ >> 3) * 128, c0_ = (u_ & 7) * 512 + ((ci_) & 1) * 256; \
        lg0 = *(const f32x4*)(F.in[8] + c0_ + 8 * cg); lg1 = *(const f32x4*)(F.in[8] + c0_ + 8 * cg + 4); lb0 = *(const f32x4*)(F.in[9] + c0_ + 8 * cg); lb1 = *(const f32x4*)(F.in[9] + c0_ + 8 * cg + 4); \
        _Pragma("unroll") for (int ps_ = 0; ps_ < 8; ++ps_) vreg[ps_] = *(const u32x4*)(Vv + (size_t)(row0_ + rb + 16 * ps_) * GW + c0_ + 8 * cg); \
        _Pragma("unroll") for (int np_ = 0; np_ < 8; ++np_) ureg[np_] = *(const u32x4*)(Uu + (size_t)(row0_ + 16 * w + i16) * GW + c0_ + 8 * quad + 32 * np_); } } while (0)
    if (F.bid < 1024) { GATE_STATS(F.bid, 0); GATE_LOAD(0); }
    bf16x8 af[4]; float bs = 0.f;
    const int nks = (w >> 1) + 1;
    for (int ci = 0; ; ++ci) {
        const int u = F.bid + F.G * (ci >> 1); if (u >= 1024) break;
        const int ch = u >> 3, g = u & 7, dc = ci & 1, row0 = ch * 128, c0 = g * 512 + dc * 256, buf = (ci >> 1) & 1;
        __syncthreads();
        if (dc == 0) {
#pragma unroll
            for (int ks = 0; ks < 4; ++ks) af[ks] = *(const bf16x8*)(WSP(bf16, WS_WSB) + (size_t)(g * 128 + 16 * w + i16) * 128 + 32 * ks + 8 * quad);
            bs = F.in[11][g * 128 + 16 * w + i16];
        }
#pragma unroll
        for (int ps = 0; ps < 8; ++ps) { const int row = rb + 16 * ps; const u32x4 x = vreg[ps]; const f32x2 st = ST[buf * 128 + row];
            f32x4 lo = (f32x4){bflo(x.x), bfhi(x.x), bflo(x.y), bfhi(x.y)}, hi = (f32x4){bflo(x.z), bfhi(x.z), bflo(x.w), bfhi(x.w)};
            lo = (lo - st.x) * st.y * lg0 + lb0; hi = (hi - st.x) * st.y * lg1 + lb1;
            u32x4 o; o.x = pk2(lo[0], lo[1]); o.y = pk2(lo[2], lo[3]); o.z = pk2(hi[0], hi[1]); o.w = pk2(hi[2], hi[3]);
            *(LAS u32x4*)(VN + row * PITCH + 16 * cg) = o; }
        u32x4 uc[8];
#pragma unroll
        for (int np = 0; np < 8; ++np) uc[np] = ureg[np];
        __syncthreads();
        { const int un = F.bid + F.G * ((ci + 1) >> 1); if (dc == 1 && un < 1024) GATE_STATS(un, buf ^ 1); }
        GATE_LOAD(ci + 1);
        const size_t grow = (size_t)(row0 + 16 * w + i16) * GW + c0 + 8 * quad;
#pragma unroll
        for (int np = 0; np < 8; ++np) {
            f32x4 acc0 = (f32x4){0.f, 0.f, 0.f, 0.f}, acc1 = acc0;
            for (int ks = 0; ks < nks; ++ks) {
                const LAS unsigned char* p = VN + (32 * ks + 8 * quad + (i16 >> 2)) * PITCH + (32 * np + 8 * (i16 & 3)) * 2;
                const s16x4 lo0 = __builtin_bit_cast(s16x4, __builtin_amdgcn_ds_read_tr16_b64_v4i16((LAS s16x4*)p));
                const s16x4 hi0 = __builtin_bit_cast(s16x4, __builtin_amdgcn_ds_read_tr16_b64_v4i16((LAS s16x4*)(p + 4 * PITCH)));
                const s16x4 lo1 = __builtin_bit_cast(s16x4, __builtin_amdgcn_ds_read_tr16_b64_v4i16((LAS s16x4*)(p + 8)));
                const s16x4 hi1 = __builtin_bit_cast(s16x4, __builtin_amdgcn_ds_read_tr16_b64_v4i16((LAS s16x4*)(p + 4 * PITCH + 8)));
                const bf16x8 vf0 = __builtin_shufflevector(lo0, hi0, 0, 1, 2, 3, 4, 5, 6, 7), vf1 = __builtin_shufflevector(lo1, hi1, 0, 1, 2, 3, 4, 5, 6, 7);
                const bf16x8 a = ks == 0 ? af[0] : (ks == 1 ? af[1] : (ks == 2 ? af[2] : af[3]));
                acc0 = __builtin_amdgcn_mfma_f32_16x16x32_bf16(vf0, a, acc0, 0, 0, 0);
                acc1 = __builtin_amdgcn_mfma_f32_16x16x32_bf16(vf1, a, acc1, 0, 0, 0);
            }
            const u32x4 uv = uc[np];
            if (U8) { u32x2 o8;
                o8.x = pk4_fp8(bflo(uv.x) * (acc0[0] + bs) * SC_U, bfhi(uv.x) * (acc0[1] + bs) * SC_U, bflo(uv.y) * (acc0[2] + bs) * SC_U, bfhi(uv.y) * (acc0[3] + bs) * SC_U);
                o8.y = pk4_fp8(bflo(uv.z) * (acc1[0] + bs) * SC_U, bfhi(uv.z) * (acc1[1] + bs) * SC_U, bflo(uv.w) * (acc1[2] + bs) * SC_U, bfhi(uv.w) * (acc1[3] + bs) * SC_U);
                *(u32x2*)(U8 + grow + 32 * np) = o8; }
            else { u32x4 o;
            o.x = pk2(bflo(uv.x) * (acc0[0] + bs), bfhi(uv.x) * (acc0[1] + bs)); o.y = pk2(bflo(uv.y) * (acc0[2] + bs), bfhi(uv.y) * (acc0[3] + bs));
            o.z = pk2(bflo(uv.z) * (acc1[0] + bs), bfhi(uv.z) * (acc1[1] + bs)); o.w = pk2(bflo(uv.w) * (acc1[2] + bs), bfhi(uv.w) * (acc1[3] + bs));
            *(u32x4*)(Uo + grow + 32 * np) = o; }
        }
    }
#undef GATE_STATS
#undef GATE_LOAD
}

__device__ __forceinline__ void attn_phase(Frame& F, bf16* Oo) {
    const int tid = F.tid, lane = F.lane, w = F.wave, i16 = lane & 15, quad = lane >> 4;
    constexpr int PITCH = 144, KROWS = 272;
    LAS unsigned char* KS = F.lds; LAS unsigned char* VS = F.lds + KROWS * PITCH;
    const bf16* Kb = WSP(bf16, WS_KB); const bf16* Vb = WSP(bf16, WS_VB); const bf16* Q = WSP(bf16, WS_Q);
    constexpr float LOG2E = 1.44269504089f, NEG = -1.0e30f;
    u32x4 kreg[5], vreg[5];
    auto load_kv = [&](int u) {
        const int b = u >> 7, qb = (u >> 2) & 31, kvh = u & 3;
#pragma unroll
        for (int i = 0; i < 5; ++i) { const int idx = tid + NTHR * i, rr = idx >> 3, chk = idx & 7; const int kp = (qb - 1) * 128 + rr;
            kreg[i] = (u32x4){0u, 0u, 0u, 0u}; vreg[i] = kreg[i];
            if (idx < KROWS * 8 && rr < 256 && kp >= 0) { const size_t off = (size_t)(b * SEQ + kp) * (4 * HD) + kvh * HD + chk * 8; kreg[i] = *(const u32x4*)(Kb + off); vreg[i] = *(const u32x4*)(Vb + off); } }
    };
    int u = F.bid;
    if (u < 512) load_kv(u);
    for (; u < 512; u += F.G) {
        const int b = u >> 7, qb = (u >> 2) & 31, kvh = u & 3;
        __syncthreads();
#pragma unroll
        for (int i = 0; i < 5; ++i) { const int idx = tid + NTHR * i, rr = idx >> 3, chk = idx & 7;
            if (idx < KROWS * 8) { *(LAS u32x4*)(KS + rr * PITCH + chk * 16) = kreg[i]; *(LAS u32x4*)(VS + rr * PITCH + chk * 16) = vreg[i]; } }
        __syncthreads();
        if (u + F.G < 512) load_kv(u + F.G);
        const int h = kvh * 8 + w; const float sink = F.in[16][h];
        const size_t qbase = (size_t)(b * SEQ + qb * 128 + i16) * D + h * HD + 8 * quad;
        bf16x8 qn0 = *(const bf16x8*)(Q + qbase), qn1 = *(const bf16x8*)(Q + qbase + 32);
#pragma unroll 2
        for (int mt = 0; mt < 8; ++mt) {
            const bf16x8 qf0 = qn0, qf1 = qn1;
            if (mt < 7) { qn0 = *(const bf16x8*)(Q + qbase + (size_t)(16 * (mt + 1)) * D); qn1 = *(const bf16x8*)(Q + qbase + (size_t)(16 * (mt + 1)) * D + 32); }
            f32x4 st[9];
#pragma unroll
            for (int kt = 0; kt < 9; ++kt) { st[kt] = (f32x4){0.f, 0.f, 0.f, 0.f};
                const LAS unsigned char* kp = KS + (16 * (mt + kt) + i16) * PITCH + 16 * quad;
                st[kt] = __builtin_amdgcn_mfma_f32_16x16x32_bf16(*(const LAS bf16x8*)kp, qf0, st[kt], 0, 0, 0);
                st[kt] = __builtin_amdgcn_mfma_f32_16x16x32_bf16(*(const LAS bf16x8*)(kp + 64), qf1, st[kt], 0, 0, 0); }
#pragma unroll
            for (int j = 0; j < 4; ++j) { st[0][j] = (i16 < 4 * quad + j) ? st[0][j] : NEG; st[8][j] = (i16 >= 4 * quad + j) ? st[8][j] : NEG; }
            if (qb == 0) {
#pragma unroll
                for (int kt = 0; kt < 8; ++kt) if (mt + kt < 8) st[kt] = (f32x4){NEG, NEG, NEG, NEG};
            }
            float mx = sink;
#pragma unroll
            for (int kt = 0; kt < 9; ++kt) mx = fmaxf(fmaxf(mx, fmaxf(st[kt][0], st[kt][1])), fmaxf(st[kt][2], st[kt][3]));
            mx = fmaxf(mx, __shfl_xor(mx, 16)); mx = fmaxf(mx, __shfl_xor(mx, 32));
            const float mxs = mx * LOG2E; float sum = 0.f;
#pragma unroll
            for (int kt = 0; kt < 9; ++kt)
#pragma unroll
                for (int j = 0; j < 4; ++j) { const float pv_ = fast_exp2(st[kt][j] * LOG2E - mxs); st[kt][j] = pv_; sum += pv_; }
            sum += __shfl_xor(sum, 16); sum += __shfl_xor(sum, 32);
            const float inv = 1.0f / (sum + fast_exp2(sink * LOG2E - mxs));
            f32x4 o[4];
#pragma unroll
            for (int dt = 0; dt < 4; ++dt) o[dt] = (f32x4){0.f, 0.f, 0.f, 0.f};
#pragma unroll
            for (int kk = 0; kk < 5; ++kk) {
                u32x4 pw; pw.x = cvt_pk_bf16(st[2 * kk][0], st[2 * kk][1]); pw.y = cvt_pk_bf16(st[2 * kk][2], st[2 * kk][3]);
                if (kk < 4) { pw.z = cvt_pk_bf16(st[2 * kk + 1][0], st[2 * kk + 1][1]); pw.w = cvt_pk_bf16(st[2 * kk + 1][2], st[2 * kk + 1][3]); } else { pw.z = 0u; pw.w = 0u; }
                const bf16x8 pf = __builtin_bit_cast(bf16x8, pw);
#pragma unroll
                for (int dt = 0; dt < 4; ++dt) {
                    const LAS unsigned char* p = VS + (16 * (mt + 2 * kk) + 4 * quad + (i16 >> 2)) * PITCH + (16 * dt + 4 * (i16 & 3)) * 2;
                    const s16x4 lo = __builtin_bit_cast(s16x4, __builtin_amdgcn_ds_read_tr16_b64_v4i16((LAS s16x4*)p));
                    const s16x4 hi = __builtin_bit_cast(s16x4, __builtin_amdgcn_ds_read_tr16_b64_v4i16((LAS s16x4*)(p + 16 * PITCH)));
                    const bf16x8 vf = __builtin_shufflevector(lo, hi, 0, 1, 2, 3, 4, 5, 6, 7);
                    o[dt] = __builtin_amdgcn_mfma_f32_16x16x32_bf16(vf, pf, o[dt], 0, 0, 0);
                }
            }
            const size_t qrow = (size_t)(b * SEQ + qb * 128 + 16 * mt + i16);
#pragma unroll
            for (int dt = 0; dt < 4; ++dt) { const f32x4 r = o[dt] * inv; *(u32x2*)(Oo + qrow * D + h * HD + 16 * dt + 4 * quad) = (u32x2){cvt_pk_bf16(r[0], r[1]), cvt_pk_bf16(r[2], r[3])}; }
        }
    }
}

__device__ __forceinline__ void scatter_phase(Frame& F) {
    const int tid = F.tid, lane = F.lane, w = F.wave;
    volatile LAS int* CN = (volatile LAS int*)F.lds;
    volatile LAS int* NEe = CN + 2048;
    volatile LAS int* BASE = NEe + 8;
    volatile LAS int* OFFS = BASE + 8;
    volatile LAS int* SL = OFFS + 8;
    const int* cnt = (const int*)F.ctl + CW_CNT;
    __syncthreads();
    for (int i = tid; i < 2048; i += NTHR) CN[i] = cnt[i];
    __syncthreads();
    { int n = 0;
#pragma unroll
      for (int q = 0; q < 4; ++q) n += CN[(lane + 64 * q) * 8 + w];
      n = (int)wave_sum((float)n); if (lane == 0) NEe[w] = n; }
    __syncthreads();
    if (tid == 0) { int tb = 0; for (int e = 0; e < 8; ++e) { BASE[e] = tb * 256; if (F.bid == 0) { ((int*)F.ctl)[CW_META + e] = NEe[e]; ((int*)F.ctl)[CW_META + 8 + e] = tb; } tb += (NEe[e] + 255) >> 8; }
        if (F.bid == 0) { ((int*)F.ctl)[CW_META + 16] = tb; ((int*)F.ctl)[CW_META + 17] = tb; } }
    __syncthreads();
    const bf16* H = WSP(bf16, WS_H); unsigned char* AS = WSP(unsigned char, WS_AS);
    for (int vb = F.bid; vb < 256; vb += F.G) {
        __syncthreads();
        { int n = 0;
#pragma unroll
          for (int q = 0; q < 4; ++q) { const int b = lane + 64 * q; n += (b < vb) ? CN[b * 8 + w] : 0; }
          n = (int)wave_sum((float)n); if (lane == 0) OFFS[w] = n; }
        __syncthreads();
        if (w == 0) {
            const int tok = vb * 64 + lane; const int ee = WSP(int, WS_TOKE)[tok]; const int e1 = ee & 0xff, e2 = (ee >> 8) & 0xff;
            const unsigned long long lt = (1ull << lane) - 1ull;
            int s1 = 0, s2 = 0;
#pragma unroll
            for (int e = 0; e < 8; ++e) { const unsigned long long m1 = __ballot(e1 == e), m2 = __ballot(e2 == e); const int base = BASE[e] + OFFS[e];
                if (e1 == e) s1 = base + __popcll(m1 & lt); if (e2 == e) s2 = base + __popcll(m1) + __popcll(m2 & lt); }
            WSP(int, WS_SLOT)[2 * tok] = s1; WSP(int, WS_SLOT)[2 * tok + 1] = s2; SL[2 * lane] = s1; SL[2 * lane + 1] = s2;
        }
        __syncthreads();
        if (tid < 128) WSP(unsigned, WS_TOKOF)[SL[tid]] = (unsigned)(vb * 64 + (tid >> 1));
        if (vb < 8) { const int n = NEe[vb], first = BASE[vb] + n, end = BASE[vb] + (((n + 255) >> 8) << 8);
            for (int r = first + tid; r < end; r += NTHR) WSP(unsigned, WS_TOKOF)[r] = 0u; }
    }
}

__device__ __forceinline__ void combine_phase(Frame& F, float* outp) {
    const int lane = F.lane; const int gw = F.bid * NWAVES + F.wave, NGW = F.G * NWAVES;
    const bf16* OE = WSP(bf16, WS_OE);
    for (int row = gw; row < M; row += NGW) {
        const int b = row / SEQ; const float* g2 = WSP(float, WS_MOD) + (size_t)(1 * NB + b) * (6 * D) + 5 * D;
        const int s1 = WSP(int, WS_SLOT)[2 * row], s2 = WSP(int, WS_SLOT)[2 * row + 1]; const f32x2 tw = WSP(f32x2, WS_TOKW)[row];
        const u32x4* p1 = (const u32x4*)(OE + (size_t)s1 * D) + lane; const u32x4* p2 = (const u32x4*)(OE + (size_t)s2 * D) + lane;
        const bool t1 = s1 >= MAIN_TILES * 256, t2 = s2 >= MAIN_TILES * 256; const float* TPp = WSP(float, WS_TP);
        const bf16* irow = WSP(bf16, WS_XB) + (size_t)row * D; float* orow = outp + (size_t)row * D;
#pragma unroll
        for (int j = 0; j < 4; ++j) { const u32x4 a = p1[64 * j], c = p2[64 * j]; const int col = 8 * (64 * j + lane);
            const u32x4 xw = *(const u32x4*)(irow + col); const f32x4 x0 = (f32x4){bflo(xw.x), bfhi(xw.x), bflo(xw.y), bfhi(xw.y)}, x1 = (f32x4){bflo(xw.z), bfhi(xw.z), bflo(xw.w), bfhi(xw.w)}, g0 = *(const f32x4*)(g2 + col), g1 = *(const f32x4*)(g2 + col + 4);
            f32x4 a0 = (f32x4){bflo(a.x), bfhi(a.x), bflo(a.y), bfhi(a.y)}, a1 = (f32x4){bflo(a.z), bfhi(a.z), bflo(a.w), bfhi(a.w)};
            f32x4 c0 = (f32x4){bflo(c.x), bfhi(c.x), bflo(c.y), bfhi(c.y)}, c1 = (f32x4){bflo(c.z), bfhi(c.z), bflo(c.w), bfhi(c.w)};
            if (t1) { a0 = (f32x4){0.f, 0.f, 0.f, 0.f}; a1 = a0;
#pragma unroll
                for (int ks = 0; ks < TAIL_KSPLIT; ++ks) { const float* q = TPp + ((size_t)ks * TAIL_ROWS + (s1 - MAIN_TILES * 256)) * D + col; a0 += *(const f32x4*)q; a1 += *(const f32x4*)(q + 4); } }
            if (t2) { c0 = (f32x4){0.f, 0.f, 0.f, 0.f}; c1 = c0;
#pragma unroll
                for (int ks = 0; ks < TAIL_KSPLIT; ++ks) { const float* q = TPp + ((size_t)ks * TAIL_ROWS + (s2 - MAIN_TILES * 256)) * D + col; c0 += *(const f32x4*)q; c1 += *(const f32x4*)(q + 4); } }
            const f32x4 y0 = a0 * tw.x + c0 * tw.y, y1 = a1 * tw.x + c1 * tw.y;
            *(f32x4*)(orow + col) = x0 + g0 * y0; *(f32x4*)(orow + col + 4) = x1 + g1 * y1; }
    }
}

constexpr int NPHASE = 17;
struct Args { const float* in[24]; float* out; unsigned char* ws; int ph_lo, ph_hi; };
__global__ void __launch_bounds__(NTHR, 2) mk_fwd(Args args) {
    extern __shared__ __attribute__((aligned(16))) unsigned char lds[];
    Frame F;
    F.lds = (LAS unsigned char*)lds; F.MISC = (volatile LAS unsigned*)(F.lds + MISC_OFF);
    F.tid = threadIdx.x; F.lane = F.tid & 63; F.wave = __builtin_amdgcn_readfirstlane(F.tid >> 6); F.G = gridDim.x; F.bid = blockIdx.x;
    F.ws = args.ws; F.ctl = (unsigned*)(args.ws + WS_CTL); F.out = args.out;
#pragma unroll
    for (int i = 0; i < 24; ++i) F.in[i] = args.in[i];
    for (int u = F.tid; u < (LDS_BYTES - MISC_OFF) / 4; u += NTHR) ((LAS unsigned*)(F.lds + MISC_OFF))[u] = 0u;
    __syncthreads();
    XcdBarrier bar; bar.bar = F.ctl + CW_BAR; bar.x = 0; bar.st = nullptr;
    if (!MK_PER_PHASE) bar = xcd_barrier_post(F.ctl + CW_BAR, F.MISC + 8);
    const int lo = args.ph_lo, hi = args.ph_hi;
#define IN(k) (lo <= (k) && (k) < hi)
#define SEAM(k) do { if (IN(k) && IN((k) + 1)) xcd_barrier(bar); } while (0)
    const float* MOD = WSP(float, WS_MOD);
    const bool grpA = (F.bid & 7) < 4;
#define CONV_PRE(lo_, hi_) do { if (grpA) { convert_items(F, lo_, hi_, F.bid * NWAVES + F.wave, F.G * NWAVES); __syncthreads(); } } while (0)
#define CONV_POST(lo_, hi_) do { if (!grpA) convert_items(F, lo_, hi_, F.bid * NWAVES + F.wave, F.G * NWAVES); } while (0)
    volatile LAS int* TB = (volatile LAS int*)(F.lds + MISC_OFF + 256);

    if (IN(0)) { for (int r_ = 0; r_ < (PROBE_DUP == 0 ? 2 : 1); ++r_) { p0_prologue(F); __syncthreads(); } } SEAM(0);
    if (IN(1)) { for (int r_ = 0; r_ < (PROBE_DUP == 1 ? 2 : 1); ++r_) norm_phase<false>(F, F.in[0], 0, 0); } SEAM(1);
    if (IN(2)) { CONV_PRE(CV_B0, CV_B1); pg8::Gemm g{WSP(bf16, WS_H), WSP(bf16, WS_WIN), 2 * D, 0, 0, nullptr}; pg8::Order S; S.init(M / 256, NIN / 256, F.G, F.bid, nullptr);
        pg8::EpiGelu E{WSP(bf16, WS_U), WSP(bf16, WS_V), F.in[7], WSP(f32x2, WS_VST)}; pg8::gemm_phase(F.lds, g, S, E);  CONV_POST(CV_B0, CV_B1); } SEAM(2);
    if (IN(3)) { if (PROBE_DUP == 3) gate_phase(F, WSP(bf16, WS_FFH)); gate_phase(F, WSP(bf16, WS_U), WSP(unsigned char, WS_FFH)); } SEAM(3);
    if (IN(4)) { CONV_PRE(CV_B1, CV_B2); pg8::Gemm g{WSP(unsigned char, WS_FFH), WSP(unsigned char, WS_WOUT), GW, 0, 0, nullptr}; pg8::Order S; S.init(M / 256, D / 256, F.G, F.bid, nullptr);
        pg8::EpiResB<true> E{F.in[0], WSP(bf16, WS_XB), MOD + 2 * D, 1.0f / (SC_U * SC_W)}; pg8::gemm_phase<pg8::EpiResB<true>, true>(F.lds, g, S, E);  CONV_POST(CV_B1, CV_B2); } SEAM(4);
    if (IN(5)) { norm_phase<false, true>(F, WSP(float, WS_XB), 0, 1); } SEAM(5);
    if (IN(6)) { CONV_PRE(CV_B2, CV_B3); pg8::Gemm g{WSP(bf16, WS_H), WSP(bf16, WS_WGU), 2 * D, 0, 0, nullptr}; pg8::Order S; S.init(M / 256, 2 * FF / 256, F.G, F.bid, nullptr);
        pg8::EpiSwiglu8 E{WSP(unsigned char, WS_FFH), FF, 1.0f, SC_HID}; pg8::gemm_phase(F.lds, g, S, E);  CONV_POST(CV_B2, CV_B3); } SEAM(6);
    if (IN(7)) { CONV_PRE(CV_B3, CV_B4); pg8::Gemm g{WSP(unsigned char, WS_FFH), WSP(unsigned char, WS_WD), FF, 0, 0, nullptr}; pg8::Order S; S.init(M / 256, D / 256, F.G, F.bid, nullptr);
        pg8::EpiResB<false> E{nullptr, WSP(bf16, WS_XB), MOD + 5 * D, 1.0f / (SC_HID * SC_W)}; pg8::gemm_phase<pg8::EpiResB<false>, true>(F.lds, g, S, E);  CONV_POST(CV_B3, CV_B4); } SEAM(7);
    if (IN(8)) { norm_phase<false, true>(F, WSP(float, WS_XB), 1, 0); } SEAM(8);
    const bool p9all = F.G != 256, p9two = F.bid >= 128;
    if (IN(9)) { if (p9all) CONV_PRE(CV_B4, CV_B5); else if (p9two && grpA) { convert_items(F, CV_B4, CV_B5, (F.bid - 128) * NWAVES + F.wave, 128 * NWAVES); __syncthreads(); }
        pg8::Gemm g{WSP(bf16, WS_H), WSP(bf16, WS_WQKV), 2 * D, 0, 0, nullptr}; pg8::Order S; S.init(M / 256, NQKV / 256, F.G, F.bid, nullptr);
        pg8::EpiQKV E{WSP(bf16, WS_Q), WSP(bf16, WS_KB), WSP(bf16, WS_VB), F.in[14], F.in[15], WSP(float, WS_CS)}; pg8::gemm_phase(F.lds, g, S, E);
        if (p9all) CONV_POST(CV_B4, CV_B5); else if (p9two && !grpA) convert_items(F, CV_B4, CV_B5, (F.bid - 128) * NWAVES + F.wave, 128 * NWAVES); } SEAM(9);
    if (IN(10)) { if (PROBE_DUP == 10) attn_phase(F, WSP(bf16, WS_FFH)); attn_phase(F, WSP(bf16, WS_Q)); } SEAM(10);
    if (IN(11)) { CONV_PRE(CV_B5, CV_B6); pg8::Gemm g{WSP(bf16, WS_Q), WSP(bf16, WS_WO), 2 * D, 0, 0, nullptr}; pg8::Order S; S.init(M / 256, D / 256, F.G, F.bid, nullptr);
        pg8::EpiResB<false> E{nullptr, WSP(bf16, WS_XB), MOD + (size_t)NB * 6 * D + 2 * D, 1.f}; pg8::gemm_phase(F.lds, g, S, E);  CONV_POST(CV_B5, CV_B6); } SEAM(11);
    if (IN(12)) { norm_phase<true, true>(F, WSP(float, WS_XB), 1, 1); } SEAM(12);
    if (IN(13)) { for (int r_ = 0; r_ < (PROBE_DUP == 13 ? 2 : 1); ++r_) scatter_phase(F); } SEAM(13);
    if (IN(14) || IN(15)) { __syncthreads(); if (F.tid < 9) TB[F.tid] = ((const int*)F.ctl)[CW_META + 8 + F.tid]; __syncthreads(); }
    if (IN(14)) { const int nT = __builtin_amdgcn_readfirstlane(TB[8]); pg8::Gemm g{WSP(unsigned char, WS_H), WSP(unsigned char, WS_MWGU), D, (size_t)2 * FFE * D, 0, WSP(unsigned, WS_TOKOF)}; pg8::Order S; S.init(nT, 2 * FFE / 256, F.G, F.bid, TB);
        pg8::EpiSwiglu8 E{WSP(unsigned char, WS_HID), FFE, 1.0f / (SC_H * SC_W), SC_HID}; pg8::gemm_phase<pg8::EpiSwiglu8, true, PG8_ALIGN, true>(F.lds, g, S, E); } SEAM(14);
    if (IN(15)) { const int nT = __builtin_amdgcn_readfirstlane(TB[8]);
        if (nT > MAIN_TILES) { pg8::Gemm g{WSP(unsigned char, WS_HID), WSP(unsigned char, WS_MWD), FFE, (size_t)D * FFE, FFE / 128 / TAIL_KSPLIT, nullptr}; pg8::Order S; S.init_tail(MAIN_TILES, nT - MAIN_TILES, D / 256, TAIL_KSPLIT, FFE / TAIL_KSPLIT, F.G, F.bid, TB);
          pg8::EpiPart E{WSP(float, WS_TP), MAIN_TILES * 256, TAIL_ROWS, FFE / TAIL_KSPLIT, 1.0f / (SC_HID * SC_W)}; pg8::gemm_phase<pg8::EpiPart, true>(F.lds, g, S, E); }
        { pg8::Gemm g{WSP(unsigned char, WS_HID), WSP(unsigned char, WS_MWD), FFE, (size_t)D * FFE, 0, nullptr}; pg8::Order S; S.init(nT < MAIN_TILES ? nT : MAIN_TILES, D / 256, F.G, F.bid, TB);
          pg8::EpiBf16 E{WSP(bf16, WS_OE), D, 1.0f / (SC_HID * SC_W)}; pg8::gemm_phase<pg8::EpiBf16, true>(F.lds, g, S, E); } } SEAM(15);
    if (IN(16)) { if (PROBE_DUP == 16) combine_phase(F, WSP(float, WS_U)); combine_phase(F, F.out); }
#undef IN
#undef SEAM
}

extern "C" void kernel_launch(void* const* d_in, const int* in_sizes, int n_in, void* d_out, int out_size, void* d_ws, size_t ws_size, hipStream_t stream) {
    static int grid = 0;
    if (grid == 0) {
        if (n_in != 24 || out_size != M * D || ws_size < WS_END) { fprintf(stderr, "kernel_launch: unexpected problem (n_in %d, out %d, ws %zu); nothing launched\n", n_in, out_size, ws_size); grid = -1; return; }
        int dev = 0, cus = 0, per_cu = 0;
        if (hipGetDevice(&dev) != hipSuccess || hipDeviceGetAttribute(&cus, hipDeviceAttributeMultiprocessorCount, dev) != hipSuccess) { grid = -1; return; }
        if (hipFuncSetAttribute((const void*)mk_fwd, hipFuncAttributeMaxDynamicSharedMemorySize, LDS_BYTES) != hipSuccess) { fprintf(stderr, "kernel_launch: hipFuncSetAttribute failed\n"); grid = -1; return; }
        if (hipOccupancyMaxActiveBlocksPerMultiprocessor(&per_cu, (const void*)mk_fwd, NTHR, LDS_BYTES) != hipSuccess || per_cu < 1) fprintf(stderr, "kernel_launch: occupancy query reports %d\n", per_cu);
        (void)hipGetLastError();
        grid = cus > 256 ? 256 : cus;
    }
    if (grid < 0) return;
    (void)hipMemsetAsync((char*)d_ws + WS_CTL, 0, CTL_ZERO_BYTES, stream);
    Args a{};
    for (int i = 0; i < 24; ++i) a.in[i] = (const float*)d_in[i];
    a.out = (float*)d_out; a.ws = (unsigned char*)d_ws;
#if MK_PER_PHASE
    for (int p = 0; p < NPHASE; ++p) { a.ph_lo = p; a.ph_hi = p + 1; hipLaunchKernelGGL(mk_fwd, dim3(grid), dim3(NTHR), LDS_BYTES, stream, a); }
#else
    a.ph_lo = 0; a.ph_hi = NPHASE; hipLaunchKernelGGL(mk_fwd, dim3(grid), dim3(NTHR), LDS_BYTES, stream, a);
#endif
}
```
